# Optimizing an MI355X kernel written in HIP

```python
import jax
import jax.numpy as jnp
from jax import lax
import numpy as np

D_MODEL = 1024
BATCH = 8
SEQ = 4096
DEPTH = 2
DEC_BATCH = 16
DEC_SEQ = 4096
PAST_LEN = 128

N_META = 16
GRID_W = 64
Q_BLOCK = 128
RMS_EPS = 1e-6
ROPE_THETA = 10000.0

MLA_HEADS = 4
MLA_Q_RANK = 384
MLA_KV_RANK = 256
MLA_NOPE = 128
MLA_ROPE = 64
MLA_V = 128
MLA_QK = MLA_NOPE + MLA_ROPE
CONV_DIM = D_MODEL // 2
CONV_WIDTH = 3
IN0_SPLITS = (MLA_Q_RANK, MLA_KV_RANK, MLA_ROPE, CONV_DIM, CONV_DIM, CONV_DIM)
IN0_DIM = MLA_Q_RANK + MLA_KV_RANK + MLA_ROPE + 3 * CONV_DIM
MIX0_DIM = MLA_HEADS * MLA_V + CONV_DIM

GQA_Q_HEADS = 8
GQA_KV_HEADS = 2
GQA_GROUP = GQA_Q_HEADS // GQA_KV_HEADS
GQA_HEAD_DIM = 128
AXIAL_DIM = GQA_HEAD_DIM // 2
IN1_DIM = (GQA_Q_HEADS + 2 * GQA_KV_HEADS) * GQA_HEAD_DIM
MIX1_DIM = GQA_Q_HEADS * GQA_HEAD_DIM

FFN_HIDDEN = ((8 * D_MODEL + 3 * 256 - 1) // (3 * 256)) * 256
N_EVEN = (DEPTH + 1) // 2
N_ODD = DEPTH // 2

kernel_name = 'hybrid_mla_conv_gqa_axial_encoder'


def rms_norm(x, g):
    xf = x.astype(jnp.float32)
    y = xf * lax.rsqrt(jnp.mean(xf * xf, axis=-1, keepdims=True) + RMS_EPS)
    return (y * g.astype(jnp.float32)).astype(x.dtype)


def rope_freqs(dim):
    return ROPE_THETA ** (-jnp.arange(0, dim, 2, dtype=jnp.float32) / dim)


def rotate(x, ang):
    half = x.shape[-1] // 2
    ang = ang.reshape((ang.shape[0],) + (1,) * (x.ndim - 3) + (half,))
    cos, sin = jnp.cos(ang), jnp.sin(ang)
    xf = x.astype(jnp.float32)
    x1, x2 = xf[..., :half], xf[..., half:]
    return jnp.concatenate([x1 * cos - x2 * sin, x2 * cos + x1 * sin], axis=-1).astype(x.dtype)


def line_angles(n_total):
    pos = jnp.arange(n_total, dtype=jnp.float32)
    return pos[:, None] * rope_freqs(MLA_ROPE)[None, :]


def axial_angles(n_tok):
    rows = n_tok // GRID_W
    row_idx = jnp.repeat(jnp.arange(rows, dtype=jnp.float32), GRID_W)
    col_idx = jnp.tile(jnp.arange(GRID_W, dtype=jnp.float32), rows)
    f = rope_freqs(AXIAL_DIM)
    meta = jnp.zeros((N_META, AXIAL_DIM // 2), jnp.float32)
    ang_r = jnp.concatenate([meta, row_idx[:, None] * f[None, :]], axis=0)
    ang_c = jnp.concatenate([meta, col_idx[:, None] * f[None, :]], axis=0)
    return ang_r, ang_c


def dense_bidir_attention(q, k, v):
    scale = q.shape[-1] ** -0.5

    def attend(qb):
        s = jnp.einsum('bqhgd,bkhd->bhgqk', qb, k, preferred_element_type=jnp.float32) * scale
        p = jax.nn.softmax(s, axis=-1).astype(v.dtype)
        return jnp.einsum('bhgqk,bkhd->bqhgd', p, v)

    b, n_total = q.shape[0], q.shape[1]
    n_tok = n_total - N_META
    n_blk = n_tok // Q_BLOCK
    out_meta = attend(q[:, :N_META])
    q_blocks = jnp.moveaxis(q[:, N_META:].reshape((b, n_blk, Q_BLOCK) + q.shape[2:]), 1, 0)
    out_blocks = lax.map(attend, q_blocks)
    out_tok = jnp.moveaxis(out_blocks, 0, 1).reshape((b, n_tok) + out_blocks.shape[3:])
    return jnp.concatenate([out_meta, out_tok], axis=1)


def mla_conv_mixer(h, w_in, q_a_g, kv_a_g, w_uq, w_ukv, q_g, k_g, conv_w, w_out):
    b, n_total, _ = h.shape
    z = h @ w_in
    c_q, c_kv, k_r, g_b, g_c, u = jnp.split(z, np.cumsum(IN0_SPLITS)[:-1].tolist(), axis=-1)
    q = (rms_norm(c_q, q_a_g) @ w_uq).reshape(b, n_total, MLA_HEADS, MLA_QK)
    kv = (rms_norm(c_kv, kv_a_g) @ w_ukv).reshape(b, n_total, MLA_HEADS, MLA_NOPE + MLA_V)
    k_nope, v = kv[..., :MLA_NOPE], kv[..., MLA_NOPE:]
    k_rope = jnp.broadcast_to(k_r[:, :, None, :], (b, n_total, MLA_HEADS, MLA_ROPE))
    k = jnp.concatenate([k_nope, k_rope], axis=-1)
    q = rms_norm(q, q_g)
    k = rms_norm(k, k_g)
    ang = line_angles(n_total)
    q = jnp.concatenate([q[..., :MLA_NOPE], rotate(q[..., MLA_NOPE:], ang)], axis=-1)
    k = jnp.concatenate([k[..., :MLA_NOPE], rotate(k[..., MLA_NOPE:], ang)], axis=-1)
    attn = dense_bidir_attention(q[:, :, :, None, :], k, v).reshape(b, n_total, MLA_HEADS * MLA_V)
    cu = g_c * u
    pad = (CONV_WIDTH - 1) // 2
    cu_p = jnp.pad(cu, ((0, 0), (pad, pad), (0, 0)))
    conv = cu_p[:, 0:n_total] * conv_w[0]
    for j in range(1, CONV_WIDTH):
        conv = conv + cu_p[:, j:j + n_total] * conv_w[j]
    y_conv = g_b * conv
    return jnp.concatenate([attn, y_conv], axis=-1) @ w_out


def gqa_axial_mixer(h, w_qkv, q_g, k_g, w_out):
    b, n_total, _ = h.shape
    qd = GQA_Q_HEADS * GQA_HEAD_DIM
    kd = GQA_KV_HEADS * GQA_HEAD_DIM
    qkv = h @ w_qkv
    q = qkv[..., :qd].reshape(b, n_total, GQA_KV_HEADS, GQA_GROUP, GQA_HEAD_DIM)
    k = qkv[..., qd:qd + kd].reshape(b, n_total, GQA_KV_HEADS, GQA_HEAD_DIM)
    v = qkv[..., qd + kd:].reshape(b, n_total, GQA_KV_HEADS, GQA_HEAD_DIM)
    q = rms_norm(q, q_g)
    k = rms_norm(k, k_g)
    ang_r, ang_c = axial_angles(n_total - N_META)
    q = jnp.concatenate([rotate(q[..., :AXIAL_DIM], ang_r), rotate(q[..., AXIAL_DIM:], ang_c)], axis=-1)
    k = jnp.concatenate([rotate(k[..., :AXIAL_DIM], ang_r), rotate(k[..., AXIAL_DIM:], ang_c)], axis=-1)
    o = dense_bidir_attention(q, k, v).reshape(b, n_total, MIX1_DIM)
    return o @ w_out


def swiglu(h, w1, w3, w2):
    return (jax.nn.silu(h @ w1) * (h @ w3)) @ w2


def trunk(x, meta_tokens, mix_norm_g, ffn_norm_g, mla_w_in, mla_q_a_g, mla_kv_a_g, mla_w_uq,
          mla_w_ukv, mla_q_g, mla_k_g, conv_w, even_w_out, gqa_w_qkv, gqa_q_g, gqa_k_g,
          odd_w_out, ffn_w1, ffn_w3, ffn_w2):
    b = x.shape[0]
    meta = jnp.broadcast_to(meta_tokens.astype(x.dtype)[None], (b, N_META, D_MODEL))
    h = jnp.concatenate([meta, x], axis=1)
    for l in range(DEPTH):
        i = l // 2
        hn = rms_norm(h, mix_norm_g[l])
        if l % 2 == 0:
            h = h + mla_conv_mixer(hn, mla_w_in[i], mla_q_a_g[i], mla_kv_a_g[i], mla_w_uq[i],
                                   mla_w_ukv[i], mla_q_g[i], mla_k_g[i], conv_w[i], even_w_out[i])
        else:
            h = h + gqa_axial_mixer(hn, gqa_w_qkv[i], gqa_q_g[i], gqa_k_g[i], odd_w_out[i])
        h = h + swiglu(rms_norm(h, ffn_norm_g[l]), ffn_w1[l], ffn_w3[l], ffn_w2[l])
    return h[:, N_META:]


def setup_inputs(seed: int = 0) -> dict:
    key = jax.random.key(seed)
    ks = jax.random.split(key, 22)

    def dense(k, shape, fan_in):
        return jax.random.normal(k, shape, jnp.float32) * fan_in ** -0.5

    def gain(k, shape):
        return 1.0 + 0.02 * jax.random.normal(k, shape, jnp.float32)

    return {
        'x_prompt': jax.random.normal(ks[0], (BATCH, SEQ, D_MODEL), jnp.float32),
        'x_sample': jax.random.normal(ks[1], (DEC_BATCH, DEC_SEQ, D_MODEL), jnp.float32),
        'meta_tokens': jax.random.normal(ks[2], (N_META, D_MODEL), jnp.float32),
        'mix_norm_g': gain(ks[3], (DEPTH, D_MODEL)),
        'ffn_norm_g': gain(ks[4], (DEPTH, D_MODEL)),
        'mla_w_in': dense(ks[5], (N_EVEN, D_MODEL, IN0_DIM), D_MODEL),
        'mla_q_a_g': gain(ks[6], (N_EVEN, MLA_Q_RANK)),
        'mla_kv_a_g': gain(ks[7], (N_EVEN, MLA_KV_RANK)),
        'mla_w_uq': dense(ks[8], (N_EVEN, MLA_Q_RANK, MLA_HEADS * MLA_QK), MLA_Q_RANK),
        'mla_w_ukv': dense(ks[9], (N_EVEN, MLA_KV_RANK, MLA_HEADS * (MLA_NOPE + MLA_V)), MLA_KV_RANK),
        'mla_q_g': gain(ks[10], (N_EVEN, MLA_QK)),
        'mla_k_g': gain(ks[11], (N_EVEN, MLA_QK)),
        'conv_w': dense(ks[12], (N_EVEN, CONV_WIDTH, CONV_DIM), CONV_WIDTH),
        'even_w_out': dense(ks[13], (N_EVEN, MIX0_DIM, D_MODEL), MIX0_DIM),
        'gqa_w_qkv': dense(ks[14], (N_ODD, D_MODEL, IN1_DIM), D_MODEL),
        'gqa_q_g': gain(ks[15], (N_ODD, GQA_HEAD_DIM)),
        'gqa_k_g': gain(ks[16], (N_ODD, GQA_HEAD_DIM)),
        'odd_w_out': dense(ks[17], (N_ODD, MIX1_DIM, D_MODEL), MIX1_DIM),
        'ffn_w1': dense(ks[18], (DEPTH, D_MODEL, FFN_HIDDEN), D_MODEL),
        'ffn_w3': dense(ks[19], (DEPTH, D_MODEL, FFN_HIDDEN), D_MODEL),
        'ffn_w2': dense(ks[20], (DEPTH, FFN_HIDDEN, D_MODEL), FFN_HIDDEN),
    }


def reference(x_prompt, x_sample, meta_tokens, mix_norm_g, ffn_norm_g, mla_w_in, mla_q_a_g,
              mla_kv_a_g, mla_w_uq, mla_w_ukv, mla_q_g, mla_k_g, conv_w, even_w_out, gqa_w_qkv,
              gqa_q_g, gqa_k_g, odd_w_out, ffn_w1, ffn_w3, ffn_w2):
    y_prompt = trunk(x_prompt, meta_tokens, mix_norm_g, ffn_norm_g, mla_w_in, mla_q_a_g, mla_kv_a_g,
                     mla_w_uq, mla_w_ukv, mla_q_g, mla_k_g, conv_w, even_w_out, gqa_w_qkv, gqa_q_g,
                     gqa_k_g, odd_w_out, ffn_w1, ffn_w3, ffn_w2)
    y_sample = trunk(x_sample, meta_tokens, mix_norm_g, ffn_norm_g, mla_w_in, mla_q_a_g, mla_kv_a_g,
                     mla_w_uq, mla_w_ukv, mla_q_g, mla_k_g, conv_w, even_w_out, gqa_w_qkv, gqa_q_g,
                     gqa_k_g, odd_w_out, ffn_w1, ffn_w3, ffn_w2)
    return (y_prompt, y_sample)
```

```cpp
#include <hip/hip_runtime.h>
#include <hip/hip_cooperative_groups.h>
#include <cstdio>
#include <cstring>
namespace cg = cooperative_groups;

#define DI __device__ __forceinline__
typedef unsigned short u16;
using bf16x8   = __attribute__((ext_vector_type(8))) short;
using f32x16   = __attribute__((ext_vector_type(16))) float;
using f32x4    = __attribute__((ext_vector_type(4))) float;
using f32x2    = __attribute__((ext_vector_type(2))) float;
using u32x4    = __attribute__((ext_vector_type(4))) unsigned;
using u32x2    = __attribute__((ext_vector_type(2))) unsigned;
using bf16x2_t = __attribute__((ext_vector_type(2))) __bf16;

constexpr int NTHREADS = 512;
constexpr int DM = 1024, NSEQ = 24, NMETA = 16, SEQ = 4096, L = SEQ + NMETA, LP = 4160, T = NSEQ * L;
constexpr int IN0 = 2240, FFN = 2816;
constexpr float EPS = 1e-6f;

constexpr size_t MiB = 1024 * 1024;
constexpr size_t OFF_W = 0, OFF_HM = 48 * MiB, OFF_R1 = 50 * MiB, OFF_R2 = 243 * MiB, OFF_R3 = 665 * MiB;
constexpr size_t W_IN = 0, W_UQ = W_IN + (size_t)2304 * 1024, W_UKV = W_UQ + 768 * 384, W_OUT0 = W_UKV + 1024 * 256,
                 W_QKV = W_OUT0 + 1024 * 1024, W_OUT1 = W_QKV + 1536 * 1024, W_13 = W_OUT1 + 1024 * 1024,
                 W_2 = W_13 + 2 * (size_t)5632 * 1024, W_END = W_2 + 2 * (size_t)1024 * FFN;
static_assert(W_END * 2 <= 48 * MiB, "weights region");

struct Params {
  const float *xp, *xs, *meta, *mix_g, *ffn_g, *w_in, *q_a_g, *kv_a_g, *w_uq, *w_ukv, *q_g0, *k_g0, *conv_w, *w_out0,
      *w_qkv, *q_g1, *k_g1, *w_out1, *w1, *w3, *w2;
  float* out;
  char* ws;
  float* hmeta;
};

DI unsigned cvtpk(float lo, float hi) { f32x2 v = {lo, hi}; return __builtin_bit_cast(unsigned, __builtin_convertvector(v, bf16x2_t)); }
DI float bf_lo(unsigned u) { return __uint_as_float(u << 16); }
DI float bf_hi(unsigned u) { return __uint_as_float(u & 0xffff0000u); }
DI u16 f2bf(float x) { return (u16)(cvtpk(x, 0.f) & 0xffffu); }
DI int obid() { int b = blockIdx.x; asm volatile("" : "+s"(b)); return b; }
DI int otid(int wv) { int t; asm volatile("v_mbcnt_lo_u32_b32 %0, -1, 0\n\tv_mbcnt_hi_u32_b32 %0, -1, %0\n\tv_lshl_or_b32 %0, %1, 6, %0" : "=&v"(t) : "s"(wv)); return t; }
DI float wave_sum(float v) {
#pragma unroll
  for (int o = 32; o; o >>= 1) v += __shfl_xor(v, o);
  return v;
}
DI float sum16(float v) {
#pragma unroll
  for (int o = 8; o; o >>= 1) v += __shfl_xor(v, o);
  return v;
}
DI void unpack8(u32x4 v, float* f) {
#pragma unroll
  for (int i = 0; i < 4; ++i) { f[2 * i] = bf_lo(v[i]); f[2 * i + 1] = bf_hi(v[i]); }
}
DI u32x4 pack8(const float* f) { return u32x4{cvtpk(f[0], f[1]), cvtpk(f[2], f[3]), cvtpk(f[4], f[5]), cvtpk(f[6], f[7])}; }

DI const float* xrow(const Params& P, int t) {
  int s = t / L, p = t - s * L;
  if (p < NMETA) return P.meta + p * DM;
  const float* base = s < 8 ? P.xp + (size_t)(s * SEQ) * DM : P.xs + (size_t)((s - 8) * SEQ) * DM;
  return base + (size_t)(p - NMETA) * DM;
}
DI float* hrow(const Params& P, int t) {
  int s = t / L, p = t - s * L;
  if (p < NMETA) return P.hmeta + (s * NMETA + p) * DM;
  return P.out + ((size_t)s * SEQ + (p - NMETA)) * DM;
}

DI void transpose_job(const float* __restrict__ src, u16* __restrict__ dst, int K, int N, int mode, const float* __restrict__ gain, const int wv) {
  const int tid = otid(wv), lane = tid & 63, wave = tid >> 6;
  const int nkb = K / 32, nnb = N / 64;
  for (int ti = obid() * 8 + wave; ti < nkb * nnb; ti += gridDim.x * 8) {
    const int kb = ti / nnb, nb = ti - kb * nnb;
    const float* sp = src + (size_t)(kb * 32) * N + nb * 64 + lane;
    float v[32];
#pragma unroll
    for (int kk = 0; kk < 32; ++kk) v[kk] = sp[(size_t)kk * N];
    if (gain) {
#pragma unroll
      for (int kk = 0; kk < 32; ++kk) v[kk] *= gain[kb * 32 + kk];
    }
    const int n = nb * 64 + lane;
    const int drow = mode ? (n >> 7) * 256 + (mode - 1) * 128 + (n & 127) : n;
    u16* dp = dst + (size_t)drow * K + kb * 32;
#pragma unroll
    for (int q = 0; q < 4; ++q) *(u32x4*)(dp + q * 8) = pack8(&v[q * 8]);
  }
}

template <bool FROMX>
DI void norm_phase(const Params& P, const float* __restrict__ g, u16* __restrict__ hn, const int wv) {
  const int tid_ = otid(wv), wave = tid_ >> 6, lane = tid_ & 63;
  for (int t = obid() * 8 + wave; t < T; t += gridDim.x * 8) {
    const float* r = xrow(P, t);
    f32x4 v[4];
    float ss = 0.f;
#pragma unroll
    for (int j = 0; j < 4; ++j) {
      v[j] = *(const f32x4*)(r + j * 256 + lane * 4);
      ss += v[j][0] * v[j][0] + v[j][1] * v[j][1] + v[j][2] * v[j][2] + v[j][3] * v[j][3];
    }
    ss = wave_sum(ss);
    const float rs = rsqrtf(ss * (1.f / DM) + EPS);
#pragma unroll
    for (int j = 0; j < 4; ++j) {
      const f32x4 gg = *(const f32x4*)(g + j * 256 + lane * 4);
      u32x2 o = {cvtpk(v[j][0] * rs * gg[0], v[j][1] * rs * gg[1]), cvtpk(v[j][2] * rs * gg[2], v[j][3] * rs * gg[3])};
      *(u32x2*)(hn + (size_t)t * DM + j * 256 + lane * 4) = o;
    }
  }
}

namespace pg8 {
#define PG8_LAS __attribute__((address_space(3)))
constexpr int BM = 256, BKK = 64, HALF = 128, HTB = HALF * BKK * 2, STAGE_BYTES = 8 * HTB, NXCD = 8, WGM = 8;
DI int lds_byte(int r, int c) { const int st = (r >> 4) * 2 + (c >> 5), rr = r & 15, cc = c & 31, ob = rr * 64 + cc * 2; return st * 1024 + (ob ^ (((ob >> 9) & 1) << 5)); }
DI void stage_rc(int b, int& R, int& C) { const int st = b / 1024, sb = b % 1024, swz = sb ^ (((sb >> 9) & 1) << 5); R = (st >> 1) * 16 + swz / 64; C = (st & 1) * 32 + (swz % 64) / 2; }
DI int perm32(int rho) { const int n = rho >> 4, i = rho & 15; return 8 * (i >> 2) + 4 * n + (i & 3); }
struct Unit { int pm, pn; };
struct Gemm { const u16* A; const u16* Bt; int M, N, K; };
struct StaticOrder {
  int nM, nN, nwg, G, c;
  DI void init(int M, int N, int G_, int c_) { nM = M / BM; nN = N / BM; nwg = nM * nN; G = G_; c = c_; }
  DI bool next(int i, Unit& u) const {
    const long Lx = (long)i * G + c; if (__builtin_amdgcn_readfirstlane((int)(Lx >= nwg))) return false;
    int wgid = (int)Lx; { const int q = nwg / NXCD, r = nwg % NXCD, xcd = wgid % NXCD, off = wgid / NXCD; wgid = (xcd < r ? xcd * (q + 1) : r * (q + 1) + (xcd - r) * q) + off; }
    const int nig = WGM * nN, gid = wgid / nig, fm = gid * WGM, gsz = (nM - fm) < WGM ? (nM - fm) : WGM;
    u.pm = __builtin_amdgcn_readfirstlane(fm + ((wgid % nig) % gsz)); u.pn = __builtin_amdgcn_readfirstlane((wgid % nig) / gsz); return true;
  }
};
template <class Epi>
DI void gemm_phase(PG8_LAS unsigned char* lds, const Gemm g, const StaticOrder& S, const Epi& E, const int wv) {
  const int tid = otid(wv), wid = __builtin_amdgcn_readfirstlane(tid >> 6), lane = tid & 63, wr = wid >> 2, wc = wid & 3, fr = lane & 15, fq = lane >> 4;
  const int K = g.K, nt = K / BKK;
  unsigned voffA[2], voffB[2];
#pragma unroll
  for (int i = 0; i < 2; ++i) { int R, C; stage_rc(tid * 16 + i * 8192, R, C); const int Rb = (R & ~31) + perm32(R & 31);
    voffA[i] = (unsigned)(R * K + C) * 2u; voffB[i] = (unsigned)(Rb * K + C) * 2u; }
  const size_t kstep = (size_t)(BKK * 2);
  const size_t hstep = (size_t)HALF * K * 2;
  const size_t tstep = 2 * hstep;
  const unsigned ldsw = (unsigned)wid * 1024u;
  const int aoff = lds_byte(wr * 64 + fr, fq * 8), boff = lds_byte(wc * 32 + fr, fq * 8);
#define PG8_SA(b, h) (((b) * 2 + (h)) * HTB)
#define PG8_SB(b, h) ((4 + (b) * 2 + (h)) * HTB)
#define PG8_STAGE(bufoff, gbase, voff) do { _Pragma("unroll") for (int _i = 0; _i < 2; ++_i) \
    __builtin_amdgcn_global_load_lds((const unsigned*)((const char*)(gbase) + (voff)[_i]), (PG8_LAS unsigned*)(lds + (bufoff) + ldsw + _i * 8192), 16, 0, 0); } while (0)
#define PG8_LDA(dst, b, h) do { _Pragma("unroll") for (int m = 0; m < 4; ++m) _Pragma("unroll") for (int k = 0; k < 2; ++k) dst[m][k] = *(const PG8_LAS bf16x8*)(lds + PG8_SA(b, h) + aoff + m * 2048 + k * 1024); } while (0)
#define PG8_LDB(dst, b, h) do { _Pragma("unroll") for (int n = 0; n < 2; ++n) _Pragma("unroll") for (int k = 0; k < 2; ++k) dst[n][k] = *(const PG8_LAS bf16x8*)(lds + PG8_SB(b, h) + boff + n * 2048 + k * 1024); } while (0)
#define PG8_MMA(ai, bj, At, Bt) do { __builtin_amdgcn_s_setprio(1); _Pragma("unroll") for (int m = 0; m < 4; ++m) _Pragma("unroll") for (int n = 0; n < 2; ++n) _Pragma("unroll") for (int k = 0; k < 2; ++k) \
    acc[ai][bj][m][n] = __builtin_amdgcn_mfma_f32_16x16x32_bf16(Bt[n][k], At[m][k], acc[ai][bj][m][n], 0, 0, 0); __builtin_amdgcn_s_setprio(0); } while (0)
#define PG8_WAIT_V(n) asm volatile("s_waitcnt vmcnt(" #n ")" ::: "memory")
#define PG8_WAIT_L(n) asm volatile("s_waitcnt lgkmcnt(" #n ")" ::: "memory")
#define PG8_BAR __builtin_amdgcn_s_barrier()
#define PG8_SCHED __builtin_amdgcn_sched_barrier(0)
  Unit cur, nxt; int ui = 0;
  if (!S.next(0, cur)) return;
  f32x4 acc[2][2][4][2];
#pragma unroll
  for (int a = 0; a < 2; ++a)
#pragma unroll
    for (int b = 0; b < 2; ++b)
#pragma unroll
      for (int m = 0; m < 4; ++m)
#pragma unroll
        for (int n = 0; n < 2; ++n) acc[a][b][m][n] = (f32x4){0.f, 0.f, 0.f, 0.f};
  bf16x8 At[4][2], B0[2][2], B1[2][2];
  const char* cA = (const char*)g.A + (size_t)cur.pm * tstep; const char* cB = (const char*)g.Bt + (size_t)cur.pn * tstep;
  PG8_STAGE(PG8_SB(0, 0), cB, voffB); PG8_STAGE(PG8_SA(0, 0), cA, voffA); PG8_STAGE(PG8_SB(0, 1), cB + hstep, voffB); PG8_STAGE(PG8_SA(0, 1), cA + hstep, voffA);
  if (wr == 1) PG8_BAR;
  PG8_WAIT_V(4); PG8_BAR;
  PG8_STAGE(PG8_SB(1, 0), cB + kstep, voffB); PG8_STAGE(PG8_SA(1, 0), cA + kstep, voffA); PG8_STAGE(PG8_SB(1, 1), cB + hstep + kstep, voffB);
  PG8_WAIT_V(6); PG8_BAR;
  for (;;) {
    const bool has_next = S.next(ui + 1, nxt);
    const char* nA = has_next ? (const char*)g.A + (size_t)nxt.pm * tstep : cA; const char* nB = has_next ? (const char*)g.Bt + (size_t)nxt.pn * tstep : cB;
#pragma nounroll
    for (int t = 0; t < nt; t += 2) {
      const bool last = (t == nt - 2);
      const char* a1 = cA + (size_t)(t + 1) * kstep;
      const char* a2 = last ? nA : cA + (size_t)(t + 2) * kstep; const char* b2 = last ? nB : cB + (size_t)(t + 2) * kstep;
      const char* a3 = a2 + kstep; const char* b3 = b2 + kstep;
      PG8_LDB(B0, 0, 0); PG8_SCHED; PG8_LDA(At, 0, 0); PG8_STAGE(PG8_SA(1, 1), a1 + hstep, voffA);
      PG8_WAIT_L(8); PG8_BAR; PG8_WAIT_L(0); PG8_MMA(0, 0, At, B0); PG8_BAR; PG8_SCHED;
      PG8_LDB(B1, 0, 1); PG8_STAGE(PG8_SB(0, 0), b2, voffB);
      PG8_BAR; PG8_WAIT_L(0); PG8_MMA(0, 1, At, B1); PG8_BAR;
      PG8_LDA(At, 0, 1); PG8_STAGE(PG8_SA(0, 0), a2, voffA);
      PG8_BAR; PG8_WAIT_L(0); PG8_MMA(1, 0, At, B0); PG8_BAR; PG8_SCHED;
      PG8_STAGE(PG8_SB(0, 1), b2 + hstep, voffB);
      PG8_WAIT_V(6); PG8_BAR; PG8_MMA(1, 1, At, B1); PG8_BAR;
      PG8_LDB(B0, 1, 0); PG8_SCHED; PG8_LDA(At, 1, 0); PG8_STAGE(PG8_SA(0, 1), a2 + hstep, voffA);
      PG8_WAIT_L(8); PG8_BAR; PG8_WAIT_L(0); PG8_MMA(0, 0, At, B0); PG8_BAR; PG8_SCHED;
      PG8_LDB(B1, 1, 1); PG8_STAGE(PG8_SB(1, 0), b3, voffB);
      PG8_BAR; PG8_WAIT_L(0); PG8_MMA(0, 1, At, B1); PG8_BAR;
      PG8_LDA(At, 1, 1); PG8_STAGE(PG8_SA(1, 0), a3, voffA);
      PG8_BAR; PG8_WAIT_L(0); PG8_MMA(1, 0, At, B0); PG8_BAR; PG8_SCHED;
      PG8_STAGE(PG8_SB(1, 1), b3 + hstep, voffB);
      PG8_WAIT_V(6); PG8_BAR; PG8_MMA(1, 1, At, B1); PG8_BAR;
    }
    E(acc, cur, wr, wc, fr, fq);
    if (!has_next) break;
#pragma unroll
    for (int a = 0; a < 2; ++a)
#pragma unroll
      for (int b = 0; b < 2; ++b)
#pragma unroll
        for (int m = 0; m < 4; ++m)
#pragma unroll
          for (int n = 0; n < 2; ++n) acc[a][b][m][n] = (f32x4){0.f, 0.f, 0.f, 0.f};
    cur = nxt; cA = nA; cB = nB; ++ui;
  }
  PG8_WAIT_V(0);
  if (wr == 0) PG8_BAR;
  PG8_BAR;
#undef PG8_SA
#undef PG8_SB
#undef PG8_STAGE
#undef PG8_LDA
#undef PG8_LDB
#undef PG8_MMA
#undef PG8_WAIT_V
#undef PG8_WAIT_L
#undef PG8_BAR
#undef PG8_SCHED
}
}

constexpr int TQ = NSEQ * SEQ;
constexpr int TP = 98816;
constexpr int SMEM_BYTES = pg8::STAGE_BYTES + 16;
typedef const f32x4 (&AccRef)[2][2][4][2];
DI u32x4 pack8v(f32x4 a, f32x4 b) { return u32x4{cvtpk(a[0], a[1]), cvtpk(a[2], a[3]), cvtpk(b[0], b[1]), cvtpk(b[2], b[3])}; }

DI int vt_pos(int p) { return (p & ~12) | ((p & 4) << 1) | ((p & 8) >> 1); }
#define EPI_ROWS_BEGIN() \
  _Pragma("unroll") for (int ai = 0; ai < 2; ++ai) { if (u.pm * 256 + ai * 128 >= T) continue;
#define EPI_ROWS_END() }

struct EpiStore {
  u16* out; int ldc; int nvalid;
  DI void operator()(AccRef acc, const pg8::Unit& u, int wr, int wc, int fr, int fq) const {
    const int row0 = u.pm * 256 + wr * 64 + fr, col0 = u.pn * 256 + wc * 32 + 8 * fq;
    EPI_ROWS_BEGIN()
#pragma unroll
      for (int m = 0; m < 4; ++m) {
        u16* rp = out + (size_t)(row0 + ai * 128 + m * 16) * ldc + col0;
#pragma unroll
        for (int bj = 0; bj < 2; ++bj)
          if (col0 + bj * 128 < nvalid) *(u32x4*)(rp + bj * 128) = pack8v(acc[ai][bj][m][0], acc[ai][bj][m][1]);
      }
    EPI_ROWS_END()
  }
};
struct EpiKV0 {
  u16* kn; u16* vt;
  DI void operator()(AccRef acc, const pg8::Unit& u, int wr, int wc, int fr, int fq) const {
    const int row0 = u.pm * 256 + wr * 64 + fr, w0 = wc * 32 + 8 * fq, head = u.pn;
    EPI_ROWS_BEGIN()
#pragma unroll
      for (int m = 0; m < 4; ++m) {
        const int row = row0 + ai * 128 + m * 16;
        const int s = row / L, p = row - s * L;
        *(u32x4*)(kn + (size_t)row * 512 + head * 128 + w0) = pack8v(acc[ai][0][m][0], acc[ai][0][m][1]);
        u16* vp = vt + (size_t)((s * 4 + head) * 128 + w0) * LP + vt_pos(p);
#pragma unroll
        for (int n = 0; n < 2; ++n)
#pragma unroll
          for (int e = 0; e < 4; ++e) vp[(size_t)(4 * n + e) * LP] = f2bf(acc[ai][1][m][n][e]);
        asm volatile("" ::: "memory");
      }
    EPI_ROWS_END()
  }
};
struct EpiQKV1 {
  u16* qk; u16* vt; const float* ss;
  DI void operator()(AccRef acc, const pg8::Unit& u, int wr, int wc, int fr, int fq) const {
    const int row0 = u.pm * 256 + wr * 64 + fr, w0 = wc * 32 + 8 * fq;
    EPI_ROWS_BEGIN()
      float rs[4];
#pragma unroll
      for (int m = 0; m < 4; ++m) rs[m] = ss[row0 + ai * 128 + m * 16];
#pragma unroll
      for (int m = 0; m < 4; ++m) rs[m] = rsqrtf(rs[m] * (1.f / DM) + EPS);
#pragma unroll
      for (int m = 0; m < 4; ++m) {
        const int row = row0 + ai * 128 + m * 16;
        if (u.pn < 5) {
#pragma unroll
          for (int bj = 0; bj < 2; ++bj)
            *(u32x4*)(qk + (size_t)row * 1280 + u.pn * 256 + bj * 128 + w0) = pack8v(acc[ai][bj][m][0] * rs[m], acc[ai][bj][m][1] * rs[m]);
        } else {
          const int s = row / L, p = row - s * L;
#pragma unroll
          for (int bj = 0; bj < 2; ++bj) {
            u16* vp = vt + (size_t)((s * 2 + bj) * 128 + w0) * LP + vt_pos(p);
#pragma unroll
            for (int n = 0; n < 2; ++n)
#pragma unroll
              for (int e = 0; e < 4; ++e) vp[(size_t)(4 * n + e) * LP] = f2bf(acc[ai][bj][m][n][e] * rs[m]);
          }
          asm volatile("" ::: "memory");
        }
      }
    EPI_ROWS_END()
  }
};
template <int MODE>
struct EpiRes {
  Params P; const u16* hsrc; u16* hdst; float* ss;
  DI void operator()(AccRef acc, const pg8::Unit& u, int wr, int wc, int fr, int fq) const {
    const int row0 = u.pm * 256 + wr * 64 + fr, col0 = u.pn * 256 + wc * 32 + 8 * fq;
    EPI_ROWS_BEGIN()
      f32x4 r[4][2][2];
      if constexpr (MODE == 0) {
#pragma unroll
        for (int m = 0; m < 4; ++m) {
          const float* src = xrow(P, row0 + ai * 128 + m * 16) + col0;
#pragma unroll
          for (int bj = 0; bj < 2; ++bj) { r[m][bj][0] = *(const f32x4*)(src + bj * 128); r[m][bj][1] = *(const f32x4*)(src + bj * 128 + 4); }
        }
      } else {
        u32x4 rb[4][2];
#pragma unroll
        for (int m = 0; m < 4; ++m)
#pragma unroll
          for (int bj = 0; bj < 2; ++bj) {
            const int rr = row0 + ai * 128 + m * 16;
            const int sr = (MODE == 3) ? rr + NMETA * ((rr >> 12) + 1) : rr;
            rb[m][bj] = *(const u32x4*)(hsrc + (size_t)sr * DM + col0 + bj * 128);
          }
#pragma unroll
        for (int m = 0; m < 4; ++m)
#pragma unroll
          for (int bj = 0; bj < 2; ++bj) {
            r[m][bj][0] = f32x4{bf_lo(rb[m][bj][0]), bf_hi(rb[m][bj][0]), bf_lo(rb[m][bj][1]), bf_hi(rb[m][bj][1])};
            r[m][bj][1] = f32x4{bf_lo(rb[m][bj][2]), bf_hi(rb[m][bj][2]), bf_lo(rb[m][bj][3]), bf_hi(rb[m][bj][3])};
          }
      }
#pragma unroll
      for (int m = 0; m < 4; ++m) {
        const int row = row0 + ai * 128 + m * 16;
        if constexpr (MODE == 4) {
          float* dst = P.out + (size_t)row * DM + col0;
#pragma unroll
          for (int bj = 0; bj < 2; ++bj) {
            *(f32x4*)(dst + bj * 128) = r[m][bj][0] + acc[ai][bj][m][0];
            *(f32x4*)(dst + bj * 128 + 4) = r[m][bj][1] + acc[ai][bj][m][1];
          }
        } else if constexpr (MODE == 2) {
          const int s = row / L, p = row - s * L;
          if (p >= NMETA) {
            float* dst = P.out + ((size_t)s * SEQ + (p - NMETA)) * DM + col0;
#pragma unroll
            for (int bj = 0; bj < 2; ++bj) {
              *(f32x4*)(dst + bj * 128) = r[m][bj][0] + acc[ai][bj][m][0];
              *(f32x4*)(dst + bj * 128 + 4) = r[m][bj][1] + acc[ai][bj][m][1];
            }
          }
        } else {
          float s2 = 0.f;
#pragma unroll
          for (int bj = 0; bj < 2; ++bj) {
            const f32x4 r0 = r[m][bj][0] + acc[ai][bj][m][0], r1 = r[m][bj][1] + acc[ai][bj][m][1];
            *(u32x4*)(hdst + (size_t)row * DM + col0 + bj * 128) = pack8v(r0, r1);
            s2 += r0[0] * r0[0] + r0[1] * r0[1] + r0[2] * r0[2] + r0[3] * r0[3] + r1[0] * r1[0] + r1[1] * r1[1] + r1[2] * r1[2] + r1[3] * r1[3];
          }
          s2 += __shfl_xor(s2, 16);
          s2 += __shfl_xor(s2, 32);
          if (fq == 0) atomicAdd(ss + row, s2);
        }
      }
    EPI_ROWS_END()
  }
};
struct EpiSwiglu {
  u16* act; const float* ss;
  DI void operator()(AccRef acc, const pg8::Unit& u, int wr, int wc, int fr, int fq) const {
    const int row0 = u.pm * 256 + wr * 64 + fr, col0 = u.pn * 128 + wc * 32 + 8 * fq;
    EPI_ROWS_BEGIN()
      float rs[4];
#pragma unroll
      for (int m = 0; m < 4; ++m) rs[m] = ss[row0 + ai * 128 + m * 16];
#pragma unroll
      for (int m = 0; m < 4; ++m) rs[m] = rsqrtf(rs[m] * (1.f / DM) + EPS);
#pragma unroll
      for (int m = 0; m < 4; ++m) {
        const int row = row0 + ai * 128 + m * 16;
        const float ne = rs[m] * -1.4426950408889634f, r2 = rs[m] * rs[m];
        f32x4 y[2];
#pragma unroll
        for (int n = 0; n < 2; ++n)
#pragma unroll
          for (int e = 0; e < 4; ++e) {
            const float a = acc[ai][0][m][n][e], b = acc[ai][1][m][n][e];
            y[n][e] = a * b * r2 * __builtin_amdgcn_rcpf(1.f + __builtin_amdgcn_exp2f(a * ne));
          }
        *(u32x4*)(act + (size_t)row * FFN + col0) = pack8v(y[0], y[1]);
      }
    EPI_ROWS_END()
  }
};
template <class Epi>
DI void run_gemm(char* smem, const u16* A, const u16* Bt, int N, int K, const Epi& E, int shift, const int wv, const int M = TP) {
  pg8::Gemm g{A, Bt, M, N, K};
  pg8::StaticOrder S; S.init(M, N, (int)gridDim.x, (int)((obid() + shift) % gridDim.x));
  pg8::gemm_phase<Epi>((PG8_LAS unsigned char*)smem, g, S, E, wv);
}

DI void e1_phase(const Params& P, const u16* __restrict__ z, u16* __restrict__ cqn, u16* __restrict__ ckvn, u16* __restrict__ kr,
                 u16* __restrict__ mix, const int wv) {
  const int tid_ = otid(wv), wave = tid_ >> 6, lane = tid_ & 63;
  for (int t = obid() * 8 + wave; t < T; t += gridDim.x * 8) {
    const u16* zr = z + (size_t)t * IN0;
    const int s = t / L, p = t - s * L;
    float f[8], o[8];
    {
      float ss = 0.f;
      if (lane < 48) { unpack8(*(const u32x4*)(zr + lane * 8), f);
#pragma unroll
        for (int e = 0; e < 8; ++e) ss += f[e] * f[e]; }
      ss = wave_sum(ss);
      const float r = rsqrtf(ss * (1.f / 384.f) + EPS);
      if (lane < 48) {
#pragma unroll
        for (int e = 0; e < 8; ++e) o[e] = f[e] * r * P.q_a_g[lane * 8 + e];
        *(u32x4*)(cqn + (size_t)t * 384 + lane * 8) = pack8(o);
      }
    }
    {
      float ss = 0.f;
      if (lane < 32) { unpack8(*(const u32x4*)(zr + 384 + lane * 8), f);
#pragma unroll
        for (int e = 0; e < 8; ++e) ss += f[e] * f[e]; }
      ss = wave_sum(ss);
      const float r = rsqrtf(ss * (1.f / 256.f) + EPS);
      if (lane < 32) {
#pragma unroll
        for (int e = 0; e < 8; ++e) o[e] = f[e] * r * P.kv_a_g[lane * 8 + e];
        *(u32x4*)(ckvn + (size_t)t * 256 + lane * 8) = pack8(o);
      }
    }
    if (lane < 8) *(u32x4*)(kr + (size_t)t * 64 + lane * 8) = *(const u32x4*)(zr + 640 + lane * 8);
    {
      const int c0 = lane * 8;
      float gb[8], a[8], b[8], cv[8];
      unpack8(*(const u32x4*)(zr + 704 + c0), gb);
      unpack8(*(const u32x4*)(zr + 1216 + c0), a); unpack8(*(const u32x4*)(zr + 1728 + c0), b);
#pragma unroll
      for (int e = 0; e < 8; ++e) cv[e] = P.conv_w[512 + c0 + e] * a[e] * b[e];
      if (p > 0) {
        unpack8(*(const u32x4*)(zr - IN0 + 1216 + c0), a); unpack8(*(const u32x4*)(zr - IN0 + 1728 + c0), b);
#pragma unroll
        for (int e = 0; e < 8; ++e) cv[e] += P.conv_w[c0 + e] * a[e] * b[e];
      }
      if (p < L - 1) {
        unpack8(*(const u32x4*)(zr + IN0 + 1216 + c0), a); unpack8(*(const u32x4*)(zr + IN0 + 1728 + c0), b);
#pragma unroll
        for (int e = 0; e < 8; ++e) cv[e] += P.conv_w[1024 + c0 + e] * a[e] * b[e];
      }
#pragma unroll
      for (int e = 0; e < 8; ++e) o[e] = gb[e] * cv[e];
      *(u32x4*)(mix + (size_t)t * DM + 512 + c0) = pack8(o);
    }
  }
}

DI void zero_vt_pad(u16* vt, int rows, const int wv) {
  const u32x4 zz = {0u, 0u, 0u, 0u};
  for (int idx = obid() * NTHREADS + otid(wv); idx < rows * 6; idx += gridDim.x * NTHREADS) {
    const int row = idx / 6, c = idx - row * 6;
    *(u32x4*)(vt + (size_t)row * LP + L + c * 8) = zz;
  }
}

constexpr float LOG2_THETA = 13.287712379549449f;
constexpr float INV_2PI = 0.15915494309189535f;
DI void rope_sc(float pos, int j, float& sn, float& cs) {
  const float fr = exp2f(-(float)j * (LOG2_THETA / 32.f));
  float tr = pos * fr * INV_2PI;
  tr -= floorf(tr);
  sn = __builtin_amdgcn_sinf(tr);
  cs = __builtin_amdgcn_cosf(tr);
}

DI void e2_phase(const Params& P, const u16* __restrict__ qpre, const u16* __restrict__ knpre, const u16* __restrict__ kr,
                 u16* __restrict__ Qo, u16* __restrict__ Ko, const int wv) {
  const int tid_ = otid(wv), wave = tid_ >> 6, lane = tid_ & 63, hd = lane >> 4, i = lane & 15;
  for (int t = obid() * 8 + wave; t < T; t += gridDim.x * 8) {
    const int s = t / L, p = t - s * L;
    float sn[2], cs[2];
    rope_sc((float)p, 2 * i, sn[0], cs[0]); rope_sc((float)p, 2 * i + 1, sn[1], cs[1]);
#pragma unroll
    for (int which = 0; which < 2; ++which) {
      float nf[8], x1[2], x2[2];
      const float* gg = which ? P.k_g0 : P.q_g0;
      if (which == 0) {
        const u16* src = qpre + (size_t)t * 768 + hd * 192;
        unpack8(*(const u32x4*)(src + 8 * i), nf);
        const unsigned a = *(const unsigned*)(src + 128 + 2 * i), b = *(const unsigned*)(src + 160 + 2 * i);
        x1[0] = bf_lo(a); x1[1] = bf_hi(a); x2[0] = bf_lo(b); x2[1] = bf_hi(b);
      } else {
        unpack8(*(const u32x4*)(knpre + (size_t)t * 512 + hd * 128 + 8 * i), nf);
        const unsigned a = *(const unsigned*)(kr + (size_t)t * 64 + 2 * i), b = *(const unsigned*)(kr + (size_t)t * 64 + 32 + 2 * i);
        x1[0] = bf_lo(a); x1[1] = bf_hi(a); x2[0] = bf_lo(b); x2[1] = bf_hi(b);
      }
      float ss = x1[0] * x1[0] + x1[1] * x1[1] + x2[0] * x2[0] + x2[1] * x2[1];
#pragma unroll
      for (int e = 0; e < 8; ++e) ss += nf[e] * nf[e];
      ss = sum16(ss);
      const float r = rsqrtf(ss * (1.f / 192.f) + EPS);
#pragma unroll
      for (int e = 0; e < 8; ++e) nf[e] = nf[e] * r * gg[8 * i + e];
      float o1[2], o2[2];
#pragma unroll
      for (int e = 0; e < 2; ++e) {
        const float a = x1[e] * r * gg[128 + 2 * i + e], b = x2[e] * r * gg[160 + 2 * i + e];
        o1[e] = a * cs[e] - b * sn[e];
        o2[e] = b * cs[e] + a * sn[e];
      }
      if (which == 0) {
        constexpr float CQ = 0.07216878364870322f * 1.4426950408889634f;
#pragma unroll
        for (int e = 0; e < 8; ++e) nf[e] *= CQ;
        o1[0] *= CQ; o1[1] *= CQ; o2[0] *= CQ; o2[1] *= CQ;
      }
      u16* dst = (which ? Ko : Qo) + (size_t)t * 768 + hd * 192;
      *(u32x4*)(dst + 8 * i) = pack8(nf);
      *(unsigned*)(dst + 128 + 2 * i) = cvtpk(o1[0], o1[1]);
      *(unsigned*)(dst + 160 + 2 * i) = cvtpk(o2[0], o2[1]);
    }
  }
}

DI void e3_phase(const Params& P, const u16* __restrict__ qk, u16* __restrict__ Qo, u16* __restrict__ Ko, const int wv) {
  const int tid_ = otid(wv), wave = tid_ >> 6, lane = tid_ & 63, i = lane & 15;
  for (int t = obid() * 8 + wave; t < T; t += gridDim.x * 8) {
    const int s = t / L, p = t - s * L;
    float snr[2], csr[2], snc[2], csc[2];
    if (p >= NMETA) {
      const float row = (float)((p - NMETA) >> 6), col = (float)((p - NMETA) & 63);
      rope_sc(row, 2 * i, snr[0], csr[0]); rope_sc(row, 2 * i + 1, snr[1], csr[1]);
      rope_sc(col, 2 * i, snc[0], csc[0]); rope_sc(col, 2 * i + 1, snc[1], csc[1]);
    } else {
      snr[0] = snr[1] = snc[0] = snc[1] = 0.f; csr[0] = csr[1] = csc[0] = csc[1] = 1.f;
    }
#pragma unroll
    for (int hp = 0; hp < 3; ++hp) {
      const int head = hp * 4 + (lane >> 4);
      if (head < 10) {
        const u16* src = qk + (size_t)t * 1280 + head * 128;
        const float* gg = head < 8 ? P.q_g1 : P.k_g1;
        const unsigned ua1 = *(const unsigned*)(src + 2 * i), ua2 = *(const unsigned*)(src + 32 + 2 * i);
        const unsigned ub1 = *(const unsigned*)(src + 64 + 2 * i), ub2 = *(const unsigned*)(src + 96 + 2 * i);
        float a1[2] = {bf_lo(ua1), bf_hi(ua1)}, a2[2] = {bf_lo(ua2), bf_hi(ua2)};
        float b1[2] = {bf_lo(ub1), bf_hi(ub1)}, b2[2] = {bf_lo(ub2), bf_hi(ub2)};
        float ss = a1[0] * a1[0] + a1[1] * a1[1] + a2[0] * a2[0] + a2[1] * a2[1] + b1[0] * b1[0] + b1[1] * b1[1] + b2[0] * b2[0] + b2[1] * b2[1];
        ss = sum16(ss);
        const float r = rsqrtf(ss * (1.f / 128.f) + EPS);
        float oa1[2], oa2[2], ob1[2], ob2[2];
#pragma unroll
        for (int e = 0; e < 2; ++e) {
          const float xa1 = a1[e] * r * gg[2 * i + e], xa2 = a2[e] * r * gg[32 + 2 * i + e];
          const float xb1 = b1[e] * r * gg[64 + 2 * i + e], xb2 = b2[e] * r * gg[96 + 2 * i + e];
          oa1[e] = xa1 * csr[e] - xa2 * snr[e]; oa2[e] = xa2 * csr[e] + xa1 * snr[e];
          ob1[e] = xb1 * csc[e] - xb2 * snc[e]; ob2[e] = xb2 * csc[e] + xb1 * snc[e];
        }
        if (head < 8) {
          constexpr float CQ = 0.08838834764831845f * 1.4426950408889634f;
#pragma unroll
          for (int e = 0; e < 2; ++e) { oa1[e] *= CQ; oa2[e] *= CQ; ob1[e] *= CQ; ob2[e] *= CQ; }
        }
        u16* dst = head < 8 ? Qo + (size_t)t * 1024 + head * 128 : Ko + (size_t)t * 256 + (head - 8) * 128;
        *(unsigned*)(dst + 2 * i) = cvtpk(oa1[0], oa1[1]);
        *(unsigned*)(dst + 32 + 2 * i) = cvtpk(oa2[0], oa2[1]);
        *(unsigned*)(dst + 64 + 2 * i) = cvtpk(ob1[0], ob1[1]);
        *(unsigned*)(dst + 96 + 2 * i) = cvtpk(ob2[0], ob2[1]);
      }
    }
  }
}

#define RAW_BAR() do { asm volatile("s_waitcnt lgkmcnt(0)" ::: "memory"); __builtin_amdgcn_s_barrier(); asm volatile("" ::: "memory"); } while (0)
DI float xhalf_max(float x) {
  auto rr = __builtin_amdgcn_permlane32_swap(__float_as_uint(x), __float_as_uint(x), false, false);
  return fmaxf(__uint_as_float(rr[0]), __uint_as_float(rr[1]));
}
DI float xhalf_sum(float x) {
  auto rr = __builtin_amdgcn_permlane32_swap(__float_as_uint(x), __float_as_uint(x), false, false);
  return __uint_as_float(rr[0]) + __uint_as_float(rr[1]);
}
DI u32x4 pack_row16(const f32x16& x, int base, float sc) {
  const unsigned a0 = cvtpk(x[base + 0] * sc, x[base + 1] * sc), a1 = cvtpk(x[base + 2] * sc, x[base + 3] * sc);
  const unsigned b0 = cvtpk(x[base + 4] * sc, x[base + 5] * sc), b1 = cvtpk(x[base + 6] * sc, x[base + 7] * sc);
  auto r0 = __builtin_amdgcn_permlane32_swap(a0, b0, false, false);
  auto r1 = __builtin_amdgcn_permlane32_swap(a1, b1, false, false);
  return u32x4{r0[0], r1[0], r0[1], r1[1]};
}
template <int DQK, int NHQ, int NHKV, bool HAS_META>
DI void attn_phase(const u16* __restrict__ Q, const u16* __restrict__ K, const u16* __restrict__ Vt, u16* __restrict__ O, const float* __restrict__ qg, const float* __restrict__ kg, char* smem, const int wv) {
  constexpr int NS = DQK / 16, CH = DQK / 8, KSTR = DQK * 2 + 16, VSTR = 144;
  constexpr int KBYTES = 64 * KSTR, VBYTES = 128 * VSTR;
  constexpr int NKC = 64 * CH / NTHREADS;
  constexpr int NT = (L + 63) / 64;
  constexpr bool EARLY_FETCH = (DQK == 128);
  constexpr int LDK = NHKV * DQK;
  static_assert(2 * (KBYTES + VBYTES) <= SMEM_BYTES, "attention LDS");
  const int tid = otid(wv), lane = tid & 63, wave = __builtin_amdgcn_readfirstlane(tid >> 6), r32 = lane & 31, hh = lane >> 5, grp = wave >> 2;
  constexpr int NF = NSEQ * NHQ * 16, nItems = NF + (HAS_META ? NSEQ * NHQ : 0);
#define A_DECODE(it_, hq_, sq_, q0_, ql_) do { if ((it_) < NF) { hq_ = ((it_) >> 4) % NHQ; sq_ = (it_) / (16 * NHQ); q0_ = NMETA + 256 * ((it_) & 15); ql_ = L; } \
    else { const int tt_ = (it_) - NF; hq_ = tt_ % NHQ; sq_ = tt_ / NHQ; q0_ = 0; ql_ = NMETA; } } while (0)
  char* kb0 = smem; char* vb0 = smem + 2 * KBYTES;
  const int lkey = tid >> 3, lc8 = tid & 7;
  const unsigned koff = (unsigned)(lkey * LDK * 2 + lc8 * 16);
  const unsigned koffL = (unsigned)(min(lkey, 15) * LDK * 2 + lc8 * 16);
  const unsigned voff = (unsigned)((lkey * LP + lc8 * 8) * 2);
  const unsigned kwoff = (unsigned)(lkey * KSTR + lc8 * 16), vwoff = (unsigned)(lkey * VSTR + lc8 * 16);
  const int G_ = (int)gridDim.x, b_ = obid();
  int item = (G_ % 8 == 0) ? (b_ % 8) * (G_ / 8) + b_ / 8 : b_;
  if (item >= nItems) return;
  u32x4 rk[NKC], rv[2];
#define A_LOADK(Kb_, tile_) do { const char* kp_ = (const char*)(Kb_) + (size_t)(tile_) * (64 * LDK * 2); const unsigned ko_ = ((tile_) == NT - 1) ? koffL : koff; \
    _Pragma("unroll") for (int i_ = 0; i_ < NKC; ++i_) rk[i_] = *(const u32x4*)(kp_ + ko_ + i_ * 128); } while (0)
#define A_LOADV(Vb_, tile_) do { const char* vp_ = (const char*)(Vb_) + (size_t)(tile_) * 128; \
    rv[0] = *(const u32x4*)(vp_ + voff); rv[1] = *(const u32x4*)(vp_ + voff + 64 * LP * 2); } while (0)
#define A_WRITEK(bi_) do { char* b_ = kb0 + (bi_) * KBYTES + kwoff; \
    _Pragma("unroll") for (int i_ = 0; i_ < NKC; ++i_) *(u32x4*)(b_ + i_ * 128) = rk[i_]; } while (0)
#define A_WRITEV(bi_) do { char* b_ = vb0 + (bi_) * VBYTES + vwoff; \
    *(u32x4*)(b_) = rv[0]; *(u32x4*)(b_ + 64 * VSTR) = rv[1]; } while (0)
#define A_FETCH(j_) do { \
        if ((j_) + 3 < NT) A_LOADK(Kb, (j_) + 3); \
        else if ((j_) == NT - 3 && has_next) A_LOADK(nKb, 0); \
        else if ((j_) == NT - 1 && has_next) A_LOADK(nKb, 1); \
        if ((j_) + 2 < NT) A_LOADV(Vb, (j_) + 2); \
        else if ((j_) == NT - 2 && has_next) A_LOADV(nVb, 0); } while (0)
#define A_QK(bi_) do { const char* sk_ = kb0 + (bi_) * KBYTES + r32 * KSTR + hh * 16; \
    _Pragma("unroll") for (int i_ = 0; i_ < 16; ++i_) { s0[i_] = 0.f; s1[i_] = 0.f; } \
    _Pragma("unroll") for (int i_ = 0; i_ < NS; ++i_) { \
      const bf16x8 k0f_ = *(const bf16x8*)(sk_ + i_ * 32); const bf16x8 k1f_ = *(const bf16x8*)(sk_ + 32 * KSTR + i_ * 32); \
      s0 = __builtin_amdgcn_mfma_f32_32x32x16_bf16(k0f_, qf[i_], s0, 0, 0, 0); \
      s1 = __builtin_amdgcn_mfma_f32_32x32x16_bf16(k1f_, qf[i_], s1, 0, 0, 0); } } while (0)
  int hq, sq, q0, qlim;
  A_DECODE(item, hq, sq, q0, qlim);
  const u16* Kb = K + (size_t)(sq * L) * LDK + (hq / (NHQ / NHKV)) * DQK;
  const u16* Vb = Vt + (size_t)((sq * NHKV + hq / (NHQ / NHKV)) * 128) * LP;
  A_LOADK(Kb, 0); A_WRITEK(0); A_LOADK(Kb, 1); A_LOADV(Vb, 0);
  if (grp == 1) { RAW_BAR(); }
  RAW_BAR();
  float l;
  f32x16 o[4], s0, s1;
  bf16x8 qf[NS], pb[4];
  for (;;) {
    const int pq = q0 + wave * 32 + r32;
    const bool valid = pq < qlim;
    const bool active = (item < NF) || (wave == 0);
    {
      const u16* qrow = Q + (size_t)(sq * L + (valid ? pq : qlim - 1)) * (NHQ * DQK) + hq * DQK + hh * 8;
#pragma unroll
      for (int i = 0; i < NS; ++i) qf[i] = *(const bf16x8*)(qrow + 16 * i);
    }
    l = 0.f;
#pragma unroll
    for (int d = 0; d < 4; ++d)
#pragma unroll
      for (int i = 0; i < 16; ++i) o[d][i] = 0.f;
    const int nitem = item + (int)gridDim.x;
    const bool has_next = nitem < nItems;
    int nhq, nsq, nq0, nqlim;
    A_DECODE(nitem, nhq, nsq, nq0, nqlim);
    const u16* nKb = K + (size_t)(nsq * L) * LDK + (nhq / (NHQ / NHKV)) * DQK;
    const u16* nVb = Vt + (size_t)((nsq * NHKV + nhq / (NHQ / NHKV)) * 128) * LP;
    RAW_BAR();
    A_WRITEK(1); A_WRITEV(0);
    __builtin_amdgcn_sched_barrier(0);
    if (active) A_QK(0);
    __builtin_amdgcn_sched_barrier(0);
    A_LOADK(Kb, 2); A_LOADV(Vb, 1);
    RAW_BAR();
    for (int j = 0; j < NT; ++j) {
      __builtin_amdgcn_s_setprio(0);
      if (active) {
        f32x2 ps2 = {0.f, 0.f};
        unsigned w_[16];
#pragma unroll
        for (int i = 0; i < 8; ++i) {
          f32x2 v;
          v[0] = __builtin_amdgcn_exp2f(s0[2 * i]); v[1] = __builtin_amdgcn_exp2f(s0[2 * i + 1]);
          if (j == NT - 1 && i >= 4) v = f32x2{0.f, 0.f};
          ps2 += v;
          w_[i] = cvtpk(v[0], v[1]);
        }
#pragma unroll
        for (int i = 0; i < 8; ++i) {
          f32x2 v;
          v[0] = __builtin_amdgcn_exp2f(s1[2 * i]); v[1] = __builtin_amdgcn_exp2f(s1[2 * i + 1]);
          if (j == NT - 1) v = f32x2{0.f, 0.f};
          ps2 += v;
          w_[8 + i] = cvtpk(v[0], v[1]);
        }
        l += xhalf_sum(ps2[0] + ps2[1]);
        pb[0] = __builtin_bit_cast(bf16x8, u32x4{w_[0], w_[1], w_[2], w_[3]});
        pb[1] = __builtin_bit_cast(bf16x8, u32x4{w_[4], w_[5], w_[6], w_[7]});
        pb[2] = __builtin_bit_cast(bf16x8, u32x4{w_[8], w_[9], w_[10], w_[11]});
        pb[3] = __builtin_bit_cast(bf16x8, u32x4{w_[12], w_[13], w_[14], w_[15]});
      }
      __builtin_amdgcn_s_setprio(2);
      RAW_BAR();
      if (j + 2 < NT) A_WRITEK(j & 1);
      else if (j == NT - 1 && has_next) A_WRITEK(0);
      if (j + 1 < NT) A_WRITEV((j + 1) & 1);
      __builtin_amdgcn_sched_barrier(0);
      if constexpr (EARLY_FETCH) { A_FETCH(j); __builtin_amdgcn_sched_barrier(0); }
        if (active)
      {
        constexpr int NQK = 2 * NS, NM = NQK + 16, RING = (DQK == 128) ? 8 : 6;
        const char* sk = kb0 + ((j + 1) & 1) * KBYTES + r32 * KSTR + hh * 16;
        const char* sv = vb0 + (j & 1) * VBYTES + r32 * VSTR + hh * 16;
        bf16x8 ring[RING];
#define A_FRAG(dst_, i_) do { if ((i_) < NQK) { dst_ = *(const bf16x8*)(sk + ((i_) & 1) * (32 * KSTR) + ((i_) >> 1) * 32); } \
          else { dst_ = *(const bf16x8*)(sv + (((i_) - NQK) & 3) * (32 * VSTR) + (((i_) - NQK) >> 2) * 32); } } while (0)
#pragma unroll
        for (int i = 0; i < 16; ++i) { s0[i] = 0.f; s1[i] = 0.f; }
#pragma unroll
        for (int i = 0; i < RING; ++i) A_FRAG(ring[i], i);
#pragma unroll
        for (int i = 0; i < NM; ++i) {
          if (i < NQK) {
            if (i & 1) s1 = __builtin_amdgcn_mfma_f32_32x32x16_bf16(ring[i % RING], qf[i >> 1], s1, 0, 0, 0);
            else       s0 = __builtin_amdgcn_mfma_f32_32x32x16_bf16(ring[i % RING], qf[i >> 1], s0, 0, 0, 0);
          } else {
            o[(i - NQK) & 3] = __builtin_amdgcn_mfma_f32_32x32x16_bf16(ring[i % RING], pb[(i - NQK) >> 2], o[(i - NQK) & 3], 0, 0, 0);
          }
          if (i + RING < NM) A_FRAG(ring[i % RING], i + RING);
          __builtin_amdgcn_sched_barrier(0);
        }
#undef A_FRAG
      }
        __builtin_amdgcn_sched_barrier(0);
      if constexpr (!EARLY_FETCH) A_FETCH(j);
      if (j == NT - 1) {
        const float inv = 1.f / l;
        u16* orow = O + (size_t)(HAS_META ? sq * L + pq : sq * SEQ + pq - NMETA) * DM + hq * 128 + hh * 8;
#pragma unroll
        for (int d = 0; d < 4; ++d)
#pragma unroll
          for (int bs = 0; bs < 2; ++bs) {
            const u32x4 w = pack_row16(o[d], 8 * bs, inv);
            if (valid) *(u32x4*)(orow + d * 32 + bs * 16) = w;
          }
      }
      RAW_BAR();
    }
    if (!has_next) break;
    item = nitem; hq = nhq; sq = nsq; q0 = nq0; qlim = nqlim; Kb = nKb; Vb = nVb;
  }
  __builtin_amdgcn_s_setprio(0);
  if (grp == 0) RAW_BAR();
  RAW_BAR();
#undef A_LOADK
#undef A_LOADV
#undef A_WRITEK
#undef A_WRITEV
#undef A_QK
#undef A_FETCH
#undef A_DECODE
}

template <int NHQ, int NHKV>
DI void attn_phase_l1(const u16* __restrict__ Q, const u16* __restrict__ K, const u16* __restrict__ Vt, u16* __restrict__ O, char* smem, const int wv) {
  constexpr int DQK = 128, NS = 8, KSTR = DQK * 2 + 16, VSTR = 144;
  constexpr int KBYTES = 64 * KSTR, VBYTES = 128 * VSTR;
  constexpr int NKC = 2;
  constexpr int NT = (L + 63) / 64;
  constexpr int LDK = NHKV * DQK;
  constexpr int NF = NSEQ * NHQ * 16;
  const int tid = otid(wv), lane = tid & 63, wave = __builtin_amdgcn_readfirstlane(tid >> 6), r32 = lane & 31, hh = lane >> 5;
  char* kb0 = smem; char* vb0 = smem + 2 * KBYTES;
  const int lkey = tid >> 3, lc8 = tid & 7;
  const unsigned koff = (unsigned)(lkey * LDK * 2 + lc8 * 16);
  const unsigned koffL = (unsigned)(min(lkey, 15) * LDK * 2 + lc8 * 16);
  const unsigned voff = (unsigned)((lkey * LP + lc8 * 8) * 2);
  const unsigned kwoff = (unsigned)(lkey * KSTR + lc8 * 16), vwoff = (unsigned)(lkey * VSTR + lc8 * 16);
  const int G_ = (int)gridDim.x, b_ = obid();
  u32x4 rk[NKC], rv[2];
#define B_LOADK(Kb_, tile_) do { const char* kp_ = (const char*)(Kb_) + (size_t)(tile_) * (64 * LDK * 2); const unsigned ko_ = ((tile_) == NT - 1) ? koffL : koff; \
    _Pragma("unroll") for (int i_ = 0; i_ < NKC; ++i_) rk[i_] = *(const u32x4*)(kp_ + ko_ + i_ * 128); } while (0)
#define B_LOADV(Vb_, tile_) do { const char* vp_ = (const char*)(Vb_) + (size_t)(tile_) * 128; \
    rv[0] = *(const u32x4*)(vp_ + voff); rv[1] = *(const u32x4*)(vp_ + voff + 64 * LP * 2); } while (0)
#define B_WRITEK(bi_) do { char* b_w = kb0 + (bi_) * KBYTES + kwoff; \
    _Pragma("unroll") for (int i_ = 0; i_ < NKC; ++i_) *(u32x4*)(b_w + i_ * 128) = rk[i_]; } while (0)
#define B_WRITEV(bi_) do { char* b_w = vb0 + (bi_) * VBYTES + vwoff; \
    *(u32x4*)(b_w) = rv[0]; *(u32x4*)(b_w + 64 * VSTR) = rv[1]; } while (0)
  f32x16 o[4], s0, s1;
  bf16x8 qf[NS], pb[4];
  for (int item = (G_ % 8 == 0) ? (b_ % 8) * (G_ / 8) + b_ / 8 : b_; item < NF; item += G_) {
    const int hq = (item >> 4) % NHQ, sq = item / (16 * NHQ), q0 = NMETA + 256 * (item & 15);
    const u16* Kb = K + (size_t)(sq * L) * LDK + (hq / (NHQ / NHKV)) * DQK;
    const u16* Vb = Vt + (size_t)((sq * NHKV + hq / (NHQ / NHKV)) * 128) * LP;
    const int pq = q0 + wave * 32 + r32;
    {
      const u16* qrow = Q + (size_t)(sq * L + pq) * (NHQ * DQK) + hq * DQK + hh * 8;
#pragma unroll
      for (int i = 0; i < NS; ++i) qf[i] = *(const bf16x8*)(qrow + 16 * i);
    }
    float l = 0.f;
#pragma unroll
    for (int d = 0; d < 4; ++d)
#pragma unroll
      for (int i = 0; i < 16; ++i) o[d][i] = 0.f;
    __syncthreads();
    B_LOADK(Kb, 0); B_WRITEK(0); B_LOADK(Kb, 1); B_WRITEK(1); B_LOADV(Vb, 0); B_WRITEV(0);
    B_LOADK(Kb, 2); B_LOADV(Vb, 1);
    __syncthreads();
    {
      const char* sk = kb0 + r32 * KSTR + hh * 16;
#pragma unroll
      for (int i = 0; i < 16; ++i) { s0[i] = 0.f; s1[i] = 0.f; }
#pragma unroll
      for (int i = 0; i < NS; ++i) {
        const bf16x8 k0f = *(const bf16x8*)(sk + i * 32), k1f = *(const bf16x8*)(sk + 32 * KSTR + i * 32);
        s0 = __builtin_amdgcn_mfma_f32_32x32x16_bf16(k0f, qf[i], s0, 0, 0, 0);
        s1 = __builtin_amdgcn_mfma_f32_32x32x16_bf16(k1f, qf[i], s1, 0, 0, 0);
      }
      unsigned w_[16]; f32x2 ps2 = {0.f, 0.f};
#pragma unroll
      for (int i = 0; i < 8; ++i) { f32x2 v; v[0] = __builtin_amdgcn_exp2f(s0[2 * i]); v[1] = __builtin_amdgcn_exp2f(s0[2 * i + 1]); ps2 += v; w_[i] = cvtpk(v[0], v[1]); }
#pragma unroll
      for (int i = 0; i < 8; ++i) { f32x2 v; v[0] = __builtin_amdgcn_exp2f(s1[2 * i]); v[1] = __builtin_amdgcn_exp2f(s1[2 * i + 1]); ps2 += v; w_[8 + i] = cvtpk(v[0], v[1]); }
      l += ps2[0] + ps2[1];
#pragma unroll
      for (int q = 0; q < 4; ++q) pb[q] = __builtin_bit_cast(bf16x8, u32x4{w_[4 * q], w_[4 * q + 1], w_[4 * q + 2], w_[4 * q + 3]});
    }
    asm volatile("s_waitcnt lgkmcnt(0)" ::: "memory"); __builtin_amdgcn_s_barrier(); asm volatile("" ::: "memory");
    for (int j = 0; j < NT; ++j) {
      if (j + 2 < NT) B_WRITEK(j & 1);
      if (j + 1 < NT) B_WRITEV((j + 1) & 1);
      __builtin_amdgcn_sched_barrier(0);
      if (j + 3 < NT) B_LOADK(Kb, j + 3);
      if (j + 2 < NT) B_LOADV(Vb, j + 2);
      __builtin_amdgcn_sched_barrier(0);
      {
        constexpr int NQK = 2 * NS, NM = NQK + 16, RING = 8;
        const char* sk = kb0 + ((j + 1) & 1) * KBYTES + r32 * KSTR + hh * 16;
        const char* sv = vb0 + (j & 1) * VBYTES + r32 * VSTR + hh * 16;
        bf16x8 ring[RING];
        unsigned w_[16]; f32x2 ps2 = {0.f, 0.f};
#define B_FRAG(dst_, i_) do { if ((i_) < NQK) { dst_ = *(const bf16x8*)(sk + ((i_) & 1) * (32 * KSTR) + ((i_) >> 1) * 32); } \
          else { dst_ = *(const bf16x8*)(sv + (((i_) - NQK) & 3) * (32 * VSTR) + (((i_) - NQK) >> 2) * 32); } } while (0)
#pragma unroll
        for (int i = 0; i < 16; ++i) { s0[i] = 0.f; s1[i] = 0.f; }
#pragma unroll
        for (int i = 0; i < RING; ++i) B_FRAG(ring[i], i);
#pragma unroll
        for (int i = 0; i < NM; ++i) {
          if (i < NQK) {
            if (i & 1) s1 = __builtin_amdgcn_mfma_f32_32x32x16_bf16(ring[i % RING], qf[i >> 1], s1, 0, 0, 0);
            else       s0 = __builtin_amdgcn_mfma_f32_32x32x16_bf16(ring[i % RING], qf[i >> 1], s0, 0, 0, 0);
          } else {
            o[(i - NQK) & 3] = __builtin_amdgcn_mfma_f32_32x32x16_bf16(ring[i % RING], pb[(i - NQK) >> 2], o[(i - NQK) & 3], 0, 0, 0);
          }
          if (i + RING < NM) B_FRAG(ring[i % RING], i + RING);
          if (i >= NQK + 2) {
            const int g = i - NQK - 2;
            f32x2 v;
            if (g < 8) { v[0] = __builtin_amdgcn_exp2f(s0[2 * g]); v[1] = __builtin_amdgcn_exp2f(s0[2 * g + 1]); }
            else       { v[0] = __builtin_amdgcn_exp2f(s1[2 * (g - 8)]); v[1] = __builtin_amdgcn_exp2f(s1[2 * (g - 8) + 1]); }
            ps2 += v; w_[g] = cvtpk(v[0], v[1]);
          }
          __builtin_amdgcn_sched_barrier(0);
        }
#pragma unroll
        for (int g = 14; g < 16; ++g) { f32x2 v; v[0] = __builtin_amdgcn_exp2f(s1[2 * (g - 8)]); v[1] = __builtin_amdgcn_exp2f(s1[2 * (g - 8) + 1]); ps2 += v; w_[g] = cvtpk(v[0], v[1]); }
#undef B_FRAG
        if (j + 1 == NT - 1) {
          ps2 = f32x2{0.f, 0.f};
#pragma unroll
          for (int g = 0; g < 4; ++g) { ps2[0] += __builtin_amdgcn_exp2f(s0[2 * g]); ps2[1] += __builtin_amdgcn_exp2f(s0[2 * g + 1]); }
#pragma unroll
          for (int g = 4; g < 16; ++g) w_[g] = 0u;
        }
        if (j + 1 < NT) {
          l += ps2[0] + ps2[1];
#pragma unroll
          for (int q = 0; q < 4; ++q) pb[q] = __builtin_bit_cast(bf16x8, u32x4{w_[4 * q], w_[4 * q + 1], w_[4 * q + 2], w_[4 * q + 3]});
        }
      }
      asm volatile("s_waitcnt lgkmcnt(0)" ::: "memory"); __builtin_amdgcn_s_barrier(); asm volatile("" ::: "memory");
    }
    {
      const float inv = 1.f / xhalf_sum(l);
      u16* orow = O + (size_t)(sq * SEQ + pq - NMETA) * DM + hq * 128 + hh * 8;
#pragma unroll
      for (int d = 0; d < 4; ++d)
#pragma unroll
        for (int bs = 0; bs < 2; ++bs) *(u32x4*)(orow + d * 32 + bs * 16) = pack_row16(o[d], 8 * bs, inv);
    }
  }
  __syncthreads();
#undef B_LOADK
#undef B_LOADV
#undef B_WRITEK
#undef B_WRITEV
}

#define XB_TMO      128
#define XB_XCNT(j)  (256  + 64 * (j))
#define XB_XSUB(j)  (1280 + 64 * (j))
#define XB_XGEN(j)  (2304 + 64 * (j))
#define XB_TOP      3328
#define XB_TOPGEN   3392
#define XCD_BAR_WORDS 3456
#define XB_SPIN_CAP (1u << 18)
#define LAS3 __attribute__((address_space(3)))
DI unsigned xb_ld(unsigned* p) { return __hip_atomic_load(p, __ATOMIC_RELAXED, __HIP_MEMORY_SCOPE_AGENT); }
DI unsigned xb_add(unsigned* p, unsigned v) { return __hip_atomic_fetch_add(p, v, __ATOMIC_RELAXED, __HIP_MEMORY_SCOPE_AGENT); }
DI unsigned xb_xcc_id() { return (unsigned)__builtin_amdgcn_s_getreg((3 << 11) | 20) & 0xFu; }
#define XB_SPIN(cond, bar) do { unsigned _sp = 0; while (cond) { __builtin_amdgcn_s_sleep(1); \
    if ((++_sp & 255u) == 0u) { if (xb_ld(&(bar)[XB_TMO])) break; if (_sp > XB_SPIN_CAP) { atomicAdd(&(bar)[XB_TMO], 1u); break; } } } } while (0)
struct XcdBarrier { unsigned* bar; unsigned x; volatile LAS3 unsigned* st; };
DI XcdBarrier xcd_barrier_post(unsigned* bar, volatile LAS3 unsigned* st) {
  XcdBarrier b; b.bar = bar; b.x = xb_xcc_id(); b.st = st;
  if (threadIdx.x == 0) (void)xb_add(&bar[XB_XCNT(b.x)], 1u);
  return b;
}
DI void xcd_barrier_complete(unsigned* bar, unsigned x, unsigned& nloc, unsigned& nx) {
  const unsigned G = gridDim.x * gridDim.y * gridDim.z;
  unsigned sum, cnt, mine, sp = 0u;
  for (;;) {
    sum = 0u; cnt = 0u; mine = 0u;
#pragma unroll
    for (unsigned j = 0; j < 16; ++j) { const unsigned c = xb_ld(&bar[XB_XCNT(j)]); sum += c; cnt += (c > 0u) ? 1u : 0u; mine = (j == x) ? c : mine; }
    if (sum == G) break;
    __builtin_amdgcn_s_sleep(1);
    if ((++sp & 255u) == 0u) { if (xb_ld(&bar[XB_TMO])) break; if (sp > XB_SPIN_CAP) { atomicAdd(&bar[XB_TMO], 1u); break; } }
  }
  nloc = mine > 0u ? mine : 1u; nx = cnt > 0u ? cnt : 1u;
}
DI void xcd_barrier(unsigned* bar, const unsigned x, volatile LAS3 unsigned* st) {
  asm volatile("s_waitcnt vmcnt(0)" ::: "memory");
  __syncthreads();
  if (threadIdx.x == 0) {
    __builtin_amdgcn_s_waitcnt(0);
    unsigned nloc = st[0], nx = st[1];
    if (nloc == 0u) { xcd_barrier_complete(bar, x, nloc, nx); st[0] = nloc; st[1] = nx; }
    const unsigned old = xb_add(&bar[XB_XSUB(x)], 1u);
    const unsigned gen = old / nloc;
    if (old + 1u == (gen + 1u) * nloc) {
      __builtin_amdgcn_fence(__ATOMIC_RELEASE, "agent");
      asm volatile("s_waitcnt vmcnt(0)" ::: "memory");
      const unsigned og = xb_add(&bar[XB_TOP], 1u);
      const unsigned tg = og / nx;
      if (og + 1u == (tg + 1u) * nx) xb_add(&bar[XB_TOPGEN], 1u);
      else XB_SPIN(xb_ld(&bar[XB_TOPGEN]) == tg, bar);
      __builtin_amdgcn_fence(__ATOMIC_ACQUIRE, "agent");
      xb_add(&bar[XB_XGEN(x)], 1u);
      asm volatile("s_waitcnt vmcnt(0)" ::: "memory");
    } else {
      XB_SPIN(xb_ld(&bar[XB_XGEN(x)]) == gen, bar);
      __builtin_amdgcn_fence(__ATOMIC_ACQUIRE, "agent");
      asm volatile("s_waitcnt vmcnt(0)" ::: "memory");
    }
  }
  __syncthreads();
}
constexpr size_t O_BAR = 47 * MiB + 512 * 1024;

template <class Tp> DI Tp* uni(Tp* p) {
  const unsigned long long v = (unsigned long long)p;
  const unsigned lo = __builtin_amdgcn_readfirstlane((unsigned)v), hi = __builtin_amdgcn_readfirstlane((unsigned)(v >> 32));
  typedef __attribute__((address_space(1))) Tp* gptr_t;
  return (Tp*)(gptr_t)(((unsigned long long)hi << 32) | lo);
}
DI Params ld_params() {
  const volatile __attribute__((address_space(4))) Params* kp = (const volatile __attribute__((address_space(4))) Params*)__builtin_amdgcn_kernarg_segment_ptr();
  Params r;
#define LDF(f_) r.f_ = uni(kp->f_)
  LDF(xp); LDF(xs); LDF(meta); LDF(mix_g); LDF(ffn_g); LDF(w_in); LDF(q_a_g); LDF(kv_a_g); LDF(w_uq); LDF(w_ukv); LDF(q_g0); LDF(k_g0);
  LDF(conv_w); LDF(w_out0); LDF(w_qkv); LDF(q_g1); LDF(k_g1); LDF(w_out1); LDF(w1); LDF(w3); LDF(w2); LDF(out); LDF(ws); LDF(hmeta);
#undef LDF
  return r;
}
constexpr size_t O_W = OFF_W, O_SS = 46 * MiB, O_R1 = OFF_R1, O_R2 = OFF_R2, O_R3 = OFF_R3, O_HBA = 800 * MiB;
constexpr size_t O_Z = O_R2, O_QPRE = O_R2, O_KNPRE = O_R2 + 145 * MiB, O_CQN = O_R3, O_CKVN = O_R3 + 73 * MiB, O_VT0 = O_R3 + 122 * MiB,
                 O_KR = O_R3 + 220 * MiB, O_ACT = O_R2, O_QKPRE = O_R2, O_VT1 = O_R3, O_Q1 = O_R3 + 49 * MiB, O_K1 = O_R3 + 242 * MiB;
constexpr size_t O_K0_IN_OUT = 145 * MiB;
#define WSP(P_, off_) ((u16*)((P_).ws + (off_)))
#define WW(P_, woff_) (WSP(P_, O_W) + (woff_))

__global__ void __launch_bounds__(NTHREADS) fwd_megakernel(Params Punused) {
  extern __shared__ __attribute__((aligned(16))) char smem[];
  cg::grid_group grid = cg::this_grid();
  const int wv = __builtin_amdgcn_readfirstlane((int)(threadIdx.x >> 6));
  volatile LAS3 unsigned* xst = (volatile LAS3 unsigned*)(smem + pg8::STAGE_BYTES);
  if (threadIdx.x < 4) xst[threadIdx.x] = 0u;
  __syncthreads();
  { const Params P = ld_params(); (void)xcd_barrier_post((unsigned*)(P.ws + O_BAR), xst); }
#define GRID_BAR() do { const Params Pb_ = ld_params(); xcd_barrier((unsigned*)(Pb_.ws + O_BAR), xb_xcc_id(), xst); } while (0)
  {
    const Params P = ld_params();
    u16* W = WSP(P, O_W);
    transpose_job(P.w_in, W + W_IN, 1024, IN0, 0, nullptr, wv);
    transpose_job(P.w_uq, W + W_UQ, 384, 768, 0, nullptr, wv);
    transpose_job(P.w_ukv, W + W_UKV, 256, 1024, 0, nullptr, wv);
    transpose_job(P.w_out0, W + W_OUT0, 1024, 1024, 0, nullptr, wv);
    transpose_job(P.w_qkv, W + W_QKV, 1024, 1536, 0, P.mix_g + DM, wv);
    transpose_job(P.w_out1, W + W_OUT1, 1024, 1024, 0, nullptr, wv);
    for (int l = 0; l < 2; ++l) {
      transpose_job(P.w1 + (size_t)l * 1024 * FFN, W + W_13 + (size_t)l * 5632 * 1024, 1024, FFN, 1, P.ffn_g + l * DM, wv);
      transpose_job(P.w3 + (size_t)l * 1024 * FFN, W + W_13 + (size_t)l * 5632 * 1024, 1024, FFN, 2, P.ffn_g + l * DM, wv);
      transpose_job(P.w2 + (size_t)l * 1024 * FFN, W + W_2 + (size_t)l * 1024 * FFN, FFN, 1024, 0, nullptr, wv);
    }
    norm_phase<true>(P, P.mix_g, WSP(P, O_R1), wv);
    float* ssq = (float*)(P.ws + O_SS);
    for (int i = obid() * NTHREADS + otid(wv); i < 3 * T; i += gridDim.x * NTHREADS) ssq[i] = 0.f;
  }
  grid.sync();
  { const Params P = ld_params();
    run_gemm(smem, WSP(P, O_R1), WW(P, W_IN), 2304, 1024, EpiStore{WSP(P, O_Z), IN0, IN0}, 0, wv); }
  GRID_BAR();
  { const Params P = ld_params();
    e1_phase(P, WSP(P, O_Z), WSP(P, O_CQN), WSP(P, O_CKVN), WSP(P, O_KR), WSP(P, O_R1), wv); }
  GRID_BAR();
  { const Params P = ld_params();
    run_gemm(smem, WSP(P, O_CQN), WW(P, W_UQ), 768, 384, EpiStore{WSP(P, O_QPRE), 768, 768}, 0, wv); }
  { const Params P = ld_params();
    run_gemm(smem, WSP(P, O_CKVN), WW(P, W_UKV), 1024, 256, EpiKV0{WSP(P, O_KNPRE), WSP(P, O_VT0)}, (int)gridDim.x - (3 * (TP / 256)) % (int)gridDim.x, wv); }
  GRID_BAR();
  { const Params P = ld_params();
    e2_phase(P, WSP(P, O_QPRE), WSP(P, O_KNPRE), WSP(P, O_KR), (u16*)P.out, (u16*)((char*)P.out + O_K0_IN_OUT), wv);
    zero_vt_pad(WSP(P, O_VT0), NSEQ * 4 * 128, wv); }
  GRID_BAR();
  { const Params P = ld_params();
    attn_phase<192, 4, 4, true>((const u16*)P.out, (const u16*)((char*)P.out + O_K0_IN_OUT), WSP(P, O_VT0), WSP(P, O_R1), P.q_g0, P.k_g0, smem, wv); }
  GRID_BAR();
  { const Params P = ld_params();
    run_gemm(smem, WSP(P, O_R1), WW(P, W_OUT0), 1024, 1024, EpiRes<0>{P, nullptr, WSP(P, O_HBA), (float*)(P.ws + O_SS)}, 0, wv); }
  GRID_BAR();
  { const Params P = ld_params();
    run_gemm(smem, WSP(P, O_HBA), WW(P, W_13), 5632, 1024, EpiSwiglu{WSP(P, O_ACT), (const float*)(P.ws + O_SS)}, 0, wv); }
  GRID_BAR();
  { const Params P = ld_params();
    run_gemm(smem, WSP(P, O_ACT), WW(P, W_2), 1024, FFN, EpiRes<1>{P, WSP(P, O_HBA), WSP(P, O_R1), (float*)(P.ws + O_SS) + T}, 0, wv); }
  GRID_BAR();
  { const Params P = ld_params();
    run_gemm(smem, WSP(P, O_R1), WW(P, W_QKV), 1536, 1024, EpiQKV1{WSP(P, O_QKPRE), WSP(P, O_VT1), (const float*)(P.ws + O_SS) + T}, 0, wv); }
  GRID_BAR();
  { const Params P = ld_params();
    e3_phase(P, WSP(P, O_QKPRE), WSP(P, O_Q1), WSP(P, O_K1), wv);
    zero_vt_pad(WSP(P, O_VT1), NSEQ * 2 * 128, wv); }
  GRID_BAR();
  { const Params P = ld_params();
    attn_phase_l1<8, 2>(WSP(P, O_Q1), WSP(P, O_K1), WSP(P, O_VT1), (u16*)P.out, smem, wv); }
  GRID_BAR();
  { const Params P = ld_params();
    run_gemm(smem, (const u16*)P.out, WW(P, W_OUT1), 1024, 1024, EpiRes<3>{P, WSP(P, O_R1), WSP(P, O_HBA), (float*)(P.ws + O_SS) + 2 * T}, 0, wv, TQ); }
  GRID_BAR();
  { const Params P = ld_params();
    run_gemm(smem, WSP(P, O_HBA), WW(P, W_13 + (size_t)5632 * 1024), 5632, 1024, EpiSwiglu{WSP(P, O_ACT), (const float*)(P.ws + O_SS) + 2 * T}, 0, wv, TQ); }
  GRID_BAR();
  { const Params P = ld_params();
    run_gemm(smem, WSP(P, O_ACT), WW(P, W_2 + (size_t)1024 * FFN), 1024, FFN, EpiRes<4>{P, WSP(P, O_HBA), nullptr, nullptr}, 0, wv, TQ); }
}

extern "C" void kernel_launch(void* const* d_in, const int* in_sizes, int n_in, void* d_out, int out_size, void* d_ws, size_t ws_size,
                              hipStream_t stream) {
  static int grid_blocks = 0;
  if (!grid_blocks) {
    if (hipFuncSetAttribute((const void*)fwd_megakernel, hipFuncAttributeMaxDynamicSharedMemorySize, SMEM_BYTES) != hipSuccess)
      fprintf(stderr, "kernel_launch: hipFuncSetAttribute failed\n");
    int dev = 0, cus = 0, per_cu = 0;
    hipGetDevice(&dev);
    hipDeviceGetAttribute(&cus, hipDeviceAttributeMultiprocessorCount, dev);
    if (hipOccupancyMaxActiveBlocksPerMultiprocessor(&per_cu, (const void*)fwd_megakernel, NTHREADS, SMEM_BYTES) != hipSuccess || per_cu < 1) per_cu = 1;
    (void)hipGetLastError();
    grid_blocks = cus * per_cu;
  }
  Params p;
  memset(&p, 0, sizeof(p));
  p.xp = (const float*)d_in[0]; p.xs = (const float*)d_in[1]; p.meta = (const float*)d_in[2]; p.mix_g = (const float*)d_in[3];
  p.ffn_g = (const float*)d_in[4]; p.w_in = (const float*)d_in[5]; p.q_a_g = (const float*)d_in[6]; p.kv_a_g = (const float*)d_in[7];
  p.w_uq = (const float*)d_in[8]; p.w_ukv = (const float*)d_in[9]; p.q_g0 = (const float*)d_in[10]; p.k_g0 = (const float*)d_in[11];
  p.conv_w = (const float*)d_in[12]; p.w_out0 = (const float*)d_in[13]; p.w_qkv = (const float*)d_in[14]; p.q_g1 = (const float*)d_in[15];
  p.k_g1 = (const float*)d_in[16]; p.w_out1 = (const float*)d_in[17]; p.w1 = (const float*)d_in[18]; p.w3 = (const float*)d_in[19];
  p.w2 = (const float*)d_in[20];
  p.out = (float*)d_out; p.ws = (char*)d_ws; p.hmeta = (float*)((char*)d_ws + OFF_HM);
  (void)hipMemsetAsync((char*)d_ws + O_BAR, 0, XCD_BAR_WORDS * sizeof(unsigned), stream);
  void* args[] = {&p};
  hipError_t e = hipLaunchCooperativeKernel((const void*)fwd_megakernel, dim3(grid_blocks), dim3(NTHREADS), args, SMEM_BYTES, stream);
  if (e != hipSuccess) fprintf(stderr, "cooperative launch failed: %s (grid %d)\n", hipGetErrorString(e), grid_blocks);
}
```

```cpp
#include <hip/hip_runtime.h>
#include <hip/hip_cooperative_groups.h>
#include <cstdio>
#include <cstring>
namespace cg = cooperative_groups;

#define DI __device__ __forceinline__
typedef unsigned short u16;
using bf16x8   = __attribute__((ext_vector_type(8))) short;
using f32x16   = __attribute__((ext_vector_type(16))) float;
using f32x4    = __attribute__((ext_vector_type(4))) float;
using f32x2    = __attribute__((ext_vector_type(2))) float;
using u32x4    = __attribute__((ext_vector_type(4))) unsigned;
using u32x2    = __attribute__((ext_vector_type(2))) unsigned;
using bf16x2_t = __attribute__((ext_vector_type(2))) __bf16;

constexpr int NTHREADS = 512;
constexpr int DM = 1024, NSEQ = 24, NMETA = 16, SEQ = 4096, L = SEQ + NMETA, LP = 4160, T = NSEQ * L;
constexpr int IN0 = 2240, FFN = 2816;
constexpr float EPS = 1e-6f;

constexpr size_t MiB = 1024 * 1024;
constexpr size_t OFF_W = 0, OFF_HM = 48 * MiB, OFF_R1 = 50 * MiB, OFF_R2 = 243 * MiB, OFF_R3 = 665 * MiB;
constexpr size_t W_IN = 0, W_UQ = W_IN + (size_t)2304 * 1024, W_UKV = W_UQ + 768 * 384, W_OUT0 = W_UKV + 1024 * 256,
                 W_QKV = W_OUT0 + 1024 * 1024, W_OUT1 = W_QKV + 1536 * 1024, W_13 = W_OUT1 + 1024 * 1024,
                 W_2 = W_13 + 2 * (size_t)5632 * 1024, W_END = W_2 + 2 * (size_t)1024 * FFN;
static_assert(W_END * 2 <= 48 * MiB, "weights region");

struct Params {
  const float *xp, *xs, *meta, *mix_g, *ffn_g, *w_in, *q_a_g, *kv_a_g, *w_uq, *w_ukv, *q_g0, *k_g0, *conv_w, *w_out0,
      *w_qkv, *q_g1, *k_g1, *w_out1, *w1, *w3, *w2;
  float* out;
  char* ws;
  float* hmeta;
};

DI unsigned cvtpk(float lo, float hi) { f32x2 v = {lo, hi}; return __builtin_bit_cast(unsigned, __builtin_convertvector(v, bf16x2_t)); }
DI float bf_lo(unsigned u) { return __uint_as_float(u << 16); }
DI float bf_hi(unsigned u) { return __uint_as_float(u & 0xffff0000u); }
DI u16 f2bf(float x) { return (u16)(cvtpk(x, 0.f) & 0xffffu); }
DI int obid() { int b = blockIdx.x; asm volatile("" : "+s"(b)); return b; }
DI int otid(int wv) { int t; asm volatile("v_mbcnt_lo_u32_b32 %0, -1, 0\n\tv_mbcnt_hi_u32_b32 %0, -1, %0\n\tv_lshl_or_b32 %0, %1, 6, %0" : "=&v"(t) : "s"(wv)); return t; }
DI float wave_sum(float v) {
#pragma unroll
  for (int o = 32; o; o >>= 1) v += __shfl_xor(v, o);
  return v;
}
DI float sum16(float v) {
#pragma unroll
  for (int o = 8; o; o >>= 1) v += __shfl_xor(v, o);
  return v;
}
DI void unpack8(u32x4 v, float* f) {
#pragma unroll
  for (int i = 0; i < 4; ++i) { f[2 * i] = bf_lo(v[i]); f[2 * i + 1] = bf_hi(v[i]); }
}
DI u32x4 pack8(const float* f) { return u32x4{cvtpk(f[0], f[1]), cvtpk(f[2], f[3]), cvtpk(f[4], f[5]), cvtpk(f[6], f[7])}; }

DI const float* xrow(const Params& P, int t) {
  int s = t / L, p = t - s * L;
  if (p < NMETA) return P.meta + p * DM;
  const float* base = s < 8 ? P.xp + (size_t)(s * SEQ) * DM : P.xs + (size_t)((s - 8) * SEQ) * DM;
  return base + (size_t)(p - NMETA) * DM;
}
DI float* hrow(const Params& P, int t) {
  int s = t / L, p = t - s * L;
  if (p < NMETA) return P.hmeta + (s * NMETA + p) * DM;
  return P.out + ((size_t)s * SEQ + (p - NMETA)) * DM;
}

DI void transpose_job(const float* __restrict__ src, u16* __restrict__ dst, int K, int N, int mode, const float* __restrict__ gain, const int wv) {
  const int tid = otid(wv), lane = tid & 63, wave = tid >> 6;
  const int nkb = K / 32, nnb = N / 64;
  for (int ti = obid() * 8 + wave; ti < nkb * nnb; ti += gridDim.x * 8) {
    const int kb = ti / nnb, nb = ti - kb * nnb;
    const float* sp = src + (size_t)(kb * 32) * N + nb * 64 + lane;
    float v[32];
#pragma unroll
    for (int kk = 0; kk < 32; ++kk) v[kk] = sp[(size_t)kk * N];
    if (gain) {
#pragma unroll
      for (int kk = 0; kk < 32; ++kk) v[kk] *= gain[kb * 32 + kk];
    }
    const int n = nb * 64 + lane;
    const int drow = mode ? (n >> 7) * 256 + (mode - 1) * 128 + (n & 127) : n;
    u16* dp = dst + (size_t)drow * K + kb * 32;
#pragma unroll
    for (int q = 0; q < 4; ++q) *(u32x4*)(dp + q * 8) = pack8(&v[q * 8]);
  }
}

template <bool FROMX>
DI void norm_phase(const Params& P, const float* __restrict__ g, u16* __restrict__ hn, const int wv) {
  const int tid_ = otid(wv), wave = tid_ >> 6, lane = tid_ & 63;
  for (int t = obid() * 8 + wave; t < T; t += gridDim.x * 8) {
    const float* r = xrow(P, t);
    f32x4 v[4];
    float ss = 0.f;
#pragma unroll
    for (int j = 0; j < 4; ++j) {
      v[j] = *(const f32x4*)(r + j * 256 + lane * 4);
      ss += v[j][0] * v[j][0] + v[j][1] * v[j][1] + v[j][2] * v[j][2] + v[j][3] * v[j][3];
    }
    ss = wave_sum(ss);
    const float rs = rsqrtf(ss * (1.f / DM) + EPS);
#pragma unroll
    for (int j = 0; j < 4; ++j) {
      const f32x4 gg = *(const f32x4*)(g + j * 256 + lane * 4);
      u32x2 o = {cvtpk(v[j][0] * rs * gg[0], v[j][1] * rs * gg[1]), cvtpk(v[j][2] * rs * gg[2], v[j][3] * rs * gg[3])};
      *(u32x2*)(hn + (size_t)t * DM + j * 256 + lane * 4) = o;
    }
  }
}

namespace pg8 {
#define PG8_LAS __attribute__((address_space(3)))
constexpr int BM = 256, BKK = 64, HALF = 128, HTB = HALF * BKK * 2, STAGE_BYTES = 8 * HTB, NXCD = 8, WGM = 8;
DI int lds_byte(int r, int c) { const int st = (r >> 4) * 2 + (c >> 5), rr = r & 15, cc = c & 31, ob = rr * 64 + cc * 2; return st * 1024 + (ob ^ (((ob >> 9) & 1) << 5)); }
DI void stage_rc(int b, int& R, int& C) { const int st = b / 1024, sb = b % 1024, swz = sb ^ (((sb >> 9) & 1) << 5); R = (st >> 1) * 16 + swz / 64; C = (st & 1) * 32 + (swz % 64) / 2; }
DI int perm32(int rho) { const int n = rho >> 4, i = rho & 15; return 8 * (i >> 2) + 4 * n + (i & 3); }
struct Unit { int pm, pn; };
struct Gemm { const u16* A; const u16* Bt; int M, N, K; };
struct StaticOrder {
  int nM, nN, nwg, G, c;
  DI void init(int M, int N, int G_, int c_) { nM = M / BM; nN = N / BM; nwg = nM * nN; G = G_; c = c_; }
  DI bool next(int i, Unit& u) const {
    const long Lx = (long)i * G + c; if (__builtin_amdgcn_readfirstlane((int)(Lx >= nwg))) return false;
    int wgid = (int)Lx; { const int q = nwg / NXCD, r = nwg % NXCD, xcd = wgid % NXCD, off = wgid / NXCD; wgid = (xcd < r ? xcd * (q + 1) : r * (q + 1) + (xcd - r) * q) + off; }
    const int nig = WGM * nN, gid = wgid / nig, fm = gid * WGM, gsz = (nM - fm) < WGM ? (nM - fm) : WGM;
    u.pm = __builtin_amdgcn_readfirstlane(fm + ((wgid % nig) % gsz)); u.pn = __builtin_amdgcn_readfirstlane((wgid % nig) / gsz); return true;
  }
};
template <class Epi>
DI void gemm_phase(PG8_LAS unsigned char* lds, const Gemm g, const StaticOrder& S, const Epi& E, const int wv) {
  const int tid = otid(wv), wid = __builtin_amdgcn_readfirstlane(tid >> 6), lane = tid & 63, wr = wid >> 2, wc = wid & 3, fr = lane & 15, fq = lane >> 4;
  const int K = g.K, nt = K / BKK;
  unsigned voffA[2], voffB[2];
#pragma unroll
  for (int i = 0; i < 2; ++i) { int R, C; stage_rc(tid * 16 + i * 8192, R, C); const int Rb = (R & ~31) + perm32(R & 31);
    voffA[i] = (unsigned)(R * K + C) * 2u; voffB[i] = (unsigned)(Rb * K + C) * 2u; }
  const size_t kstep = (size_t)(BKK * 2);
  const size_t hstep = (size_t)HALF * K * 2;
  const size_t tstep = 2 * hstep;
  const unsigned ldsw = (unsigned)wid * 1024u;
  const int aoff = lds_byte(wr * 64 + fr, fq * 8), boff = lds_byte(wc * 32 + fr, fq * 8);
#define PG8_SA(b, h) (((b) * 2 + (h)) * HTB)
#define PG8_SB(b, h) ((4 + (b) * 2 + (h)) * HTB)
#define PG8_STAGE(bufoff, gbase, voff) do { _Pragma("unroll") for (int _i = 0; _i < 2; ++_i) \
    __builtin_amdgcn_global_load_lds((const unsigned*)((const char*)(gbase) + (voff)[_i]), (PG8_LAS unsigned*)(lds + (bufoff) + ldsw + _i * 8192), 16, 0, 0); } while (0)
#define PG8_LDA(dst, b, h) do { _Pragma("unroll") for (int m = 0; m < 4; ++m) _Pragma("unroll") for (int k = 0; k < 2; ++k) dst[m][k] = *(const PG8_LAS bf16x8*)(lds + PG8_SA(b, h) + aoff + m * 2048 + k * 1024); } while (0)
#define PG8_LDB(dst, b, h) do { _Pragma("unroll") for (int n = 0; n < 2; ++n) _Pragma("unroll") for (int k = 0; k < 2; ++k) dst[n][k] = *(const PG8_LAS bf16x8*)(lds + PG8_SB(b, h) + boff + n * 2048 + k * 1024); } while (0)
#define PG8_MMA(ai, bj, At, Bt) do { __builtin_amdgcn_s_setprio(1); _Pragma("unroll") for (int m = 0; m < 4; ++m) _Pragma("unroll") for (int n = 0; n < 2; ++n) _Pragma("unroll") for (int k = 0; k < 2; ++k) \
    acc[ai][bj][m][n] = __builtin_amdgcn_mfma_f32_16x16x32_bf16(Bt[n][k], At[m][k], acc[ai][bj][m][n], 0, 0, 0); __builtin_amdgcn_s_setprio(0); } while (0)
#define PG8_WAIT_V(n) asm volatile("s_waitcnt vmcnt(" #n ")" ::: "memory")
#define PG8_WAIT_L(n) asm volatile("s_waitcnt lgkmcnt(" #n ")" ::: "memory")
#define PG8_BAR __builtin_amdgcn_s_barrier()
#define PG8_SCHED __builtin_amdgcn_sched_barrier(0)
  Unit cur, nxt; int ui = 0;
  if (!S.next(0, cur)) return;
  f32x4 acc[2][2][4][2];
#pragma unroll
  for (int a = 0; a < 2; ++a)
#pragma unroll
    for (int b = 0; b < 2; ++b)
#pragma unroll
      for (int m = 0; m < 4; ++m)
#pragma unroll
        for (int n = 0; n < 2; ++n) acc[a][b][m][n] = (f32x4){0.f, 0.f, 0.f, 0.f};
  bf16x8 At[4][2], B0[2][2], B1[2][2];
  const char* cA = (const char*)g.A + (size_t)cur.pm * tstep; const char* cB = (const char*)g.Bt + (size_t)cur.pn * tstep;
  PG8_STAGE(PG8_SB(0, 0), cB, voffB); PG8_STAGE(PG8_SA(0, 0), cA, voffA); PG8_STAGE(PG8_SB(0, 1), cB + hstep, voffB); PG8_STAGE(PG8_SA(0, 1), cA + hstep, voffA);
  if (wr == 1) PG8_BAR;
  PG8_WAIT_V(4); PG8_BAR;
  PG8_STAGE(PG8_SB(1, 0), cB + kstep, voffB); PG8_STAGE(PG8_SA(1, 0), cA + kstep, voffA); PG8_STAGE(PG8_SB(1, 1), cB + hstep + kstep, voffB);
  PG8_WAIT_V(6); PG8_BAR;
  for (;;) {
    const bool has_next = S.next(ui + 1, nxt);
    const char* nA = has_next ? (const char*)g.A + (size_t)nxt.pm * tstep : cA; const char* nB = has_next ? (const char*)g.Bt + (size_t)nxt.pn * tstep : cB;
#pragma nounroll
    for (int t = 0; t < nt; t += 2) {
      const bool last = (t == nt - 2);
      const char* a1 = cA + (size_t)(t + 1) * kstep;
      const char* a2 = last ? nA : cA + (size_t)(t + 2) * kstep; const char* b2 = last ? nB : cB + (size_t)(t + 2) * kstep;
      const char* a3 = a2 + kstep; const char* b3 = b2 + kstep;
      PG8_LDB(B0, 0, 0); PG8_SCHED; PG8_LDA(At, 0, 0); PG8_STAGE(PG8_SA(1, 1), a1 + hstep, voffA);
      PG8_WAIT_L(8); PG8_BAR; PG8_WAIT_L(0); PG8_MMA(0, 0, At, B0); PG8_BAR; PG8_SCHED;
      PG8_LDB(B1, 0, 1); PG8_STAGE(PG8_SB(0, 0), b2, voffB);
      PG8_BAR; PG8_WAIT_L(0); PG8_MMA(0, 1, At, B1); PG8_BAR;
      PG8_LDA(At, 0, 1); PG8_STAGE(PG8_SA(0, 0), a2, voffA);
      PG8_BAR; PG8_WAIT_L(0); PG8_MMA(1, 0, At, B0); PG8_BAR; PG8_SCHED;
      PG8_STAGE(PG8_SB(0, 1), b2 + hstep, voffB);
      PG8_WAIT_V(6); PG8_BAR; PG8_MMA(1, 1, At, B1); PG8_BAR;
      PG8_LDB(B0, 1, 0); PG8_SCHED; PG8_LDA(At, 1, 0); PG8_STAGE(PG8_SA(0, 1), a2 + hstep, voffA);
      PG8_WAIT_L(8); PG8_BAR; PG8_WAIT_L(0); PG8_MMA(0, 0, At, B0); PG8_BAR; PG8_SCHED;
      PG8_LDB(B1, 1, 1); PG8_STAGE(PG8_SB(1, 0), b3, voffB);
      PG8_BAR; PG8_WAIT_L(0); PG8_MMA(0, 1, At, B1); PG8_BAR;
      PG8_LDA(At, 1, 1); PG8_STAGE(PG8_SA(1, 0), a3, voffA);
      PG8_BAR; PG8_WAIT_L(0); PG8_MMA(1, 0, At, B0); PG8_BAR; PG8_SCHED;
      PG8_STAGE(PG8_SB(1, 1), b3 + hstep, voffB);
      PG8_WAIT_V(6); PG8_BAR; PG8_MMA(1, 1, At, B1); PG8_BAR;
    }
    E(acc, cur, wr, wc, fr, fq);
    if (!has_next) break;
#pragma unroll
    for (int a = 0; a < 2; ++a)
#pragma unroll
      for (int b = 0; b < 2; ++b)
#pragma unroll
        for (int m = 0; m < 4; ++m)
#pragma unroll
          for (int n = 0; n < 2; ++n) acc[a][b][m][n] = (f32x4){0.f, 0.f, 0.f, 0.f};
    cur = nxt; cA = nA; cB = nB; ++ui;
  }
  PG8_WAIT_V(0);
  if (wr == 0) PG8_BAR;
  PG8_BAR;
#undef PG8_SA
#undef PG8_SB
#undef PG8_STAGE
#undef PG8_LDA
#undef PG8_LDB
#undef PG8_MMA
#undef PG8_WAIT_V
#undef PG8_WAIT_L
#undef PG8_BAR
#undef PG8_SCHED
}
}

constexpr int TQ = NSEQ * SEQ;
constexpr int TP = 98816;
constexpr int SMEM_BYTES = pg8::STAGE_BYTES + 16;
typedef const f32x4 (&AccRef)[2][2][4][2];
DI u32x4 pack8v(f32x4 a, f32x4 b) { return u32x4{cvtpk(a[0], a[1]), cvtpk(a[2], a[3]), cvtpk(b[0], b[1]), cvtpk(b[2], b[3])}; }

DI int vt_pos(int p) { return (p & ~12) | ((p & 4) << 1) | ((p & 8) >> 1); }
#define EPI_ROWS_BEGIN() \
  _Pragma("unroll") for (int ai = 0; ai < 2; ++ai) { if (u.pm * 256 + ai * 128 >= T) continue;
#define EPI_ROWS_END() }

struct EpiStore {
  u16* out; int ldc; int nvalid;
  DI void operator()(AccRef acc, const pg8::Unit& u, int wr, int wc, int fr, int fq) const {
    const int row0 = u.pm * 256 + wr * 64 + fr, col0 = u.pn * 256 + wc * 32 + 8 * fq;
    EPI_ROWS_BEGIN()
#pragma unroll
      for (int m = 0; m < 4; ++m) {
        u16* rp = out + (size_t)(row0 + ai * 128 + m * 16) * ldc + col0;
#pragma unroll
        for (int bj = 0; bj < 2; ++bj)
          if (col0 + bj * 128 < nvalid) *(u32x4*)(rp + bj * 128) = pack8v(acc[ai][bj][m][0], acc[ai][bj][m][1]);
      }
    EPI_ROWS_END()
  }
};
struct EpiKV0 {
  u16* kn; u16* vt;
  DI void operator()(AccRef acc, const pg8::Unit& u, int wr, int wc, int fr, int fq) const {
    const int row0 = u.pm * 256 + wr * 64 + fr, w0 = wc * 32 + 8 * fq, head = u.pn;
    EPI_ROWS_BEGIN()
#pragma unroll
      for (int m = 0; m < 4; ++m) {
        const int row = row0 + ai * 128 + m * 16;
        const int s = row / L, p = row - s * L;
        *(u32x4*)(kn + (size_t)row * 512 + head * 128 + w0) = pack8v(acc[ai][0][m][0], acc[ai][0][m][1]);
        u16* vp = vt + (size_t)((s * 4 + head) * 128 + w0) * LP + vt_pos(p);
#pragma unroll
        for (int n = 0; n < 2; ++n)
#pragma unroll
          for (int e = 0; e < 4; ++e) vp[(size_t)(4 * n + e) * LP] = f2bf(acc[ai][1][m][n][e]);
        asm volatile("" ::: "memory");
      }
    EPI_ROWS_END()
  }
};
struct EpiQKV1 {
  u16* qk; u16* vt; const float* ss;
  DI void operator()(AccRef acc, const pg8::Unit& u, int wr, int wc, int fr, int fq) const {
    const int row0 = u.pm * 256 + wr * 64 + fr, w0 = wc * 32 + 8 * fq;
    EPI_ROWS_BEGIN()
      float rs[4];
#pragma unroll
      for (int m = 0; m < 4; ++m) rs[m] = ss[row0 + ai * 128 + m * 16];
#pragma unroll
      for (int m = 0; m < 4; ++m) rs[m] = rsqrtf(rs[m] * (1.f / DM) + EPS);
#pragma unroll
      for (int m = 0; m < 4; ++m) {
        const int row = row0 + ai * 128 + m * 16;
        if (u.pn < 5) {
#pragma unroll
          for (int bj = 0; bj < 2; ++bj)
            *(u32x4*)(qk + (size_t)row * 1280 + u.pn * 256 + bj * 128 + w0) = pack8v(acc[ai][bj][m][0] * rs[m], acc[ai][bj][m][1] * rs[m]);
        } else {
          const int s = row / L, p = row - s * L;
#pragma unroll
          for (int bj = 0; bj < 2; ++bj) {
            u16* vp = vt + (size_t)((s * 2 + bj) * 128 + w0) * LP + vt_pos(p);
#pragma unroll
            for (int n = 0; n < 2; ++n)
#pragma unroll
              for (int e = 0; e < 4; ++e) vp[(size_t)(4 * n + e) * LP] = f2bf(acc[ai][bj][m][n][e] * rs[m]);
          }
          asm volatile("" ::: "memory");
        }
      }
    EPI_ROWS_END()
  }
};
template <int MODE>
struct EpiRes {
  Params P; const u16* hsrc; u16* hdst; float* ss;
  DI void operator()(AccRef acc, const pg8::Unit& u, int wr, int wc, int fr, int fq) const {
    const int row0 = u.pm * 256 + wr * 64 + fr, col0 = u.pn * 256 + wc * 32 + 8 * fq;
    EPI_ROWS_BEGIN()
      f32x4 r[4][2][2];
      if constexpr (MODE == 0) {
#pragma unroll
        for (int m = 0; m < 4; ++m) {
          const float* src = xrow(P, row0 + ai * 128 + m * 16) + col0;
#pragma unroll
          for (int bj = 0; bj < 2; ++bj) { r[m][bj][0] = *(const f32x4*)(src + bj * 128); r[m][bj][1] = *(const f32x4*)(src + bj * 128 + 4); }
        }
      } else {
        u32x4 rb[4][2];
#pragma unroll
        for (int m = 0; m < 4; ++m)
#pragma unroll
          for (int bj = 0; bj < 2; ++bj) {
            const int rr = row0 + ai * 128 + m * 16;
            const int sr = (MODE == 3) ? rr + NMETA * ((rr >> 12) + 1) : rr;
            rb[m][bj] = *(const u32x4*)(hsrc + (size_t)sr * DM + col0 + bj * 128);
          }
#pragma unroll
        for (int m = 0; m < 4; ++m)
#pragma unroll
          for (int bj = 0; bj < 2; ++bj) {
            r[m][bj][0] = f32x4{bf_lo(rb[m][bj][0]), bf_hi(rb[m][bj][0]), bf_lo(rb[m][bj][1]), bf_hi(rb[m][bj][1])};
            r[m][bj][1] = f32x4{bf_lo(rb[m][bj][2]), bf_hi(rb[m][bj][2]), bf_lo(rb[m][bj][3]), bf_hi(rb[m][bj][3])};
          }
      }
#pragma unroll
      for (int m = 0; m < 4; ++m) {
        const int row = row0 + ai * 128 + m * 16;
        if constexpr (MODE == 4) {
          float* dst = P.out + (size_t)row * DM + col0;
#pragma unroll
          for (int bj = 0; bj < 2; ++bj) {
            *(f32x4*)(dst + bj * 128) = r[m][bj][0] + acc[ai][bj][m][0];
            *(f32x4*)(dst + bj * 128 + 4) = r[m][bj][1] + acc[ai][bj][m][1];
          }
        } else if constexpr (MODE == 2) {
          const int s = row / L, p = row - s * L;
          if (p >= NMETA) {
            float* dst = P.out + ((size_t)s * SEQ + (p - NMETA)) * DM + col0;
#pragma unroll
            for (int bj = 0; bj < 2; ++bj) {
              *(f32x4*)(dst + bj * 128) = r[m][bj][0] + acc[ai][bj][m][0];
              *(f32x4*)(dst + bj * 128 + 4) = r[m][bj][1] + acc[ai][bj][m][1];
            }
          }
        } else {
          float s2 = 0.f;
#pragma unroll
          for (int bj = 0; bj < 2; ++bj) {
            const f32x4 r0 = r[m][bj][0] + acc[ai][bj][m][0], r1 = r[m][bj][1] + acc[ai][bj][m][1];
            *(u32x4*)(hdst + (size_t)row * DM + col0 + bj * 128) = pack8v(r0, r1);
            s2 += r0[0] * r0[0] + r0[1] * r0[1] + r0[2] * r0[2] + r0[3] * r0[3] + r1[0] * r1[0] + r1[1] * r1[1] + r1[2] * r1[2] + r1[3] * r1[3];
          }
          s2 += __shfl_xor(s2, 16);
          s2 += __shfl_xor(s2, 32);
          if (fq == 0) atomicAdd(ss + row, s2);
        }
      }
    EPI_ROWS_END()
  }
};
struct EpiSwiglu {
  u16* act; const float* ss;
  DI void operator()(AccRef acc, const pg8::Unit& u, int wr, int wc, int fr, int fq) const {
    const int row0 = u.pm * 256 + wr * 64 + fr, col0 = u.pn * 128 + wc * 32 + 8 * fq;
    EPI_ROWS_BEGIN()
      float rs[4];
#pragma unroll
      for (int m = 0; m < 4; ++m) rs[m] = ss[row0 + ai * 128 + m * 16];
#pragma unroll
      for (int m = 0; m < 4; ++m) rs[m] = rsqrtf(rs[m] * (1.f / DM) + EPS);
#pragma unroll
      for (int m = 0; m < 4; ++m) {
        const int row = row0 + ai * 128 + m * 16;
        const float ne = rs[m] * -1.4426950408889634f, r2 = rs[m] * rs[m];
        f32x4 y[2];
#pragma unroll
        for (int n = 0; n < 2; ++n)
#pragma unroll
          for (int e = 0; e < 4; ++e) {
            const float a = acc[ai][0][m][n][e], b = acc[ai][1][m][n][e];
            y[n][e] = a * b * r2 * __builtin_amdgcn_rcpf(1.f + __builtin_amdgcn_exp2f(a * ne));
          }
        *(u32x4*)(act + (size_t)row * FFN + col0) = pack8v(y[0], y[1]);
      }
    EPI_ROWS_END()
  }
};
template <class Epi>
DI void run_gemm(char* smem, const u16* A, const u16* Bt, int N, int K, const Epi& E, int shift, const int wv, const int M = TP) {
  pg8::Gemm g{A, Bt, M, N, K};
  pg8::StaticOrder S; S.init(M, N, (int)gridDim.x, (int)((obid() + shift) % gridDim.x));
  pg8::gemm_phase<Epi>((PG8_LAS unsigned char*)smem, g, S, E, wv);
}

DI void e1_phase(const Params& P, const u16* __restrict__ z, u16* __restrict__ cqn, u16* __restrict__ ckvn, u16* __restrict__ kr,
                 u16* __restrict__ mix, const int wv) {
  const int tid_ = otid(wv), wave = tid_ >> 6, lane = tid_ & 63;
  for (int t = obid() * 8 + wave; t < T; t += gridDim.x * 8) {
    const u16* zr = z + (size_t)t * IN0;
    const int s = t / L, p = t - s * L;
    float f[8], o[8];
    {
      float ss = 0.f;
      if (lane < 48) { unpack8(*(const u32x4*)(zr + lane * 8), f);
#pragma unroll
        for (int e = 0; e < 8; ++e) ss += f[e] * f[e]; }
      ss = wave_sum(ss);
      const float r = rsqrtf(ss * (1.f / 384.f) + EPS);
      if (lane < 48) {
#pragma unroll
        for (int e = 0; e < 8; ++e) o[e] = f[e] * r * P.q_a_g[lane * 8 + e];
        *(u32x4*)(cqn + (size_t)t * 384 + lane * 8) = pack8(o);
      }
    }
    {
      float ss = 0.f;
      if (lane < 32) { unpack8(*(const u32x4*)(zr + 384 + lane * 8), f);
#pragma unroll
        for (int e = 0; e < 8; ++e) ss += f[e] * f[e]; }
      ss = wave_sum(ss);
      const float r = rsqrtf(ss * (1.f / 256.f) + EPS);
      if (lane < 32) {
#pragma unroll
        for (int e = 0; e < 8; ++e) o[e] = f[e] * r * P.kv_a_g[lane * 8 + e];
        *(u32x4*)(ckvn + (size_t)t * 256 + lane * 8) = pack8(o);
      }
    }
    if (lane < 8) *(u32x4*)(kr + (size_t)t * 64 + lane * 8) = *(const u32x4*)(zr + 640 + lane * 8);
    {
      const int c0 = lane * 8;
      float gb[8], a[8], b[8], cv[8];
      unpack8(*(const u32x4*)(zr + 704 + c0), gb);
      unpack8(*(const u32x4*)(zr + 1216 + c0), a); unpack8(*(const u32x4*)(zr + 1728 + c0), b);
#pragma unroll
      for (int e = 0; e < 8; ++e) cv[e] = P.conv_w[512 + c0 + e] * a[e] * b[e];
      if (p > 0) {
        unpack8(*(const u32x4*)(zr - IN0 + 1216 + c0), a); unpack8(*(const u32x4*)(zr - IN0 + 1728 + c0), b);
#pragma unroll
        for (int e = 0; e < 8; ++e) cv[e] += P.conv_w[c0 + e] * a[e] * b[e];
      }
      if (p < L - 1) {
        unpack8(*(const u32x4*)(zr + IN0 + 1216 + c0), a); unpack8(*(const u32x4*)(zr + IN0 + 1728 + c0), b);
#pragma unroll
        for (int e = 0; e < 8; ++e) cv[e] += P.conv_w[1024 + c0 + e] * a[e] * b[e];
      }
#pragma unroll
      for (int e = 0; e < 8; ++e) o[e] = gb[e] * cv[e];
      *(u32x4*)(mix + (size_t)t * DM + 512 + c0) = pack8(o);
    }
  }
}

DI void zero_vt_pad(u16* vt, int rows, const int wv) {
  const u32x4 zz = {0u, 0u, 0u, 0u};
  for (int idx = obid() * NTHREADS + otid(wv); idx < rows * 6; idx += gridDim.x * NTHREADS) {
    const int row = idx / 6, c = idx - row * 6;
    *(u32x4*)(vt + (size_t)row * LP + L + c * 8) = zz;
  }
}

constexpr float LOG2_THETA = 13.287712379549449f;
constexpr float INV_2PI = 0.15915494309189535f;
DI void rope_sc(float pos, int j, float& sn, float& cs) {
  const float fr = exp2f(-(float)j * (LOG2_THETA / 32.f));
  float tr = pos * fr * INV_2PI;
  tr -= floorf(tr);
  sn = __builtin_amdgcn_sinf(tr);
  cs = __builtin_amdgcn_cosf(tr);
}

DI void e2_phase(const Params& P, const u16* __restrict__ qpre, const u16* __restrict__ knpre, const u16* __restrict__ kr,
                 u16* __restrict__ Qo, u16* __restrict__ Ko, const int wv) {
  const int tid_ = otid(wv), wave = tid_ >> 6, lane = tid_ & 63, hd = lane >> 4, i = lane & 15;
  for (int t = obid() * 8 + wave; t < T; t += gridDim.x * 8) {
    const int s = t / L, p = t - s * L;
    float sn[2], cs[2];
    rope_sc((float)p, 2 * i, sn[0], cs[0]); rope_sc((float)p, 2 * i + 1, sn[1], cs[1]);
#pragma unroll
    for (int which = 0; which < 2; ++which) {
      float nf[8], x1[2], x2[2];
      const float* gg = which ? P.k_g0 : P.q_g0;
      if (which == 0) {
        const u16* src = qpre + (size_t)t * 768 + hd * 192;
        unpack8(*(const u32x4*)(src + 8 * i), nf);
        const unsigned a = *(const unsigned*)(src + 128 + 2 * i), b = *(const unsigned*)(src + 160 + 2 * i);
        x1[0] = bf_lo(a); x1[1] = bf_hi(a); x2[0] = bf_lo(b); x2[1] = bf_hi(b);
      } else {
        unpack8(*(const u32x4*)(knpre + (size_t)t * 512 + hd * 128 + 8 * i), nf);
        const unsigned a = *(const unsigned*)(kr + (size_t)t * 64 + 2 * i), b = *(const unsigned*)(kr + (size_t)t * 64 + 32 + 2 * i);
        x1[0] = bf_lo(a); x1[1] = bf_hi(a); x2[0] = bf_lo(b); x2[1] = bf_hi(b);
      }
      float ss = x1[0] * x1[0] + x1[1] * x1[1] + x2[0] * x2[0] + x2[1] * x2[1];
#pragma unroll
      for (int e = 0; e < 8; ++e) ss += nf[e] * nf[e];
      ss = sum16(ss);
      const float r = rsqrtf(ss * (1.f / 192.f) + EPS);
#pragma unroll
      for (int e = 0; e < 8; ++e) nf[e] = nf[e] * r * gg[8 * i + e];
      float o1[2], o2[2];
#pragma unroll
      for (int e = 0; e < 2; ++e) {
        const float a = x1[e] * r * gg[128 + 2 * i + e], b = x2[e] * r * gg[160 + 2 * i + e];
        o1[e] = a * cs[e] - b * sn[e];
        o2[e] = b * cs[e] + a * sn[e];
      }
      if (which == 0) {
        constexpr float CQ = 0.07216878364870322f * 1.4426950408889634f;
#pragma unroll
        for (int e = 0; e < 8; ++e) nf[e] *= CQ;
        o1[0] *= CQ; o1[1] *= CQ; o2[0] *= CQ; o2[1] *= CQ;
      }
      u16* dst = (which ? Ko : Qo) + (size_t)t * 768 + hd * 192;
      *(u32x4*)(dst + 8 * i) = pack8(nf);
      *(unsigned*)(dst + 128 + 2 * i) = cvtpk(o1[0], o1[1]);
      *(unsigned*)(dst + 160 + 2 * i) = cvtpk(o2[0], o2[1]);
    }
  }
}

DI void e3_phase(const Params& P, const u16* __restrict__ qk, u16* __restrict__ Qo, u16* __restrict__ Ko, const int wv) {
  const int tid_ = otid(wv), wave = tid_ >> 6, lane = tid_ & 63, i = lane & 15;
  for (int t = obid() * 8 + wave; t < T; t += gridDim.x * 8) {
    const int s = t / L, p = t - s * L;
    float snr[2], csr[2], snc[2], csc[2];
    if (p >= NMETA) {
      const float row = (float)((p - NMETA) >> 6), col = (float)((p - NMETA) & 63);
      rope_sc(row, 2 * i, snr[0], csr[0]); rope_sc(row, 2 * i + 1, snr[1], csr[1]);
      rope_sc(col, 2 * i, snc[0], csc[0]); rope_sc(col, 2 * i + 1, snc[1], csc[1]);
    } else {
      snr[0] = snr[1] = snc[0] = snc[1] = 0.f; csr[0] = csr[1] = csc[0] = csc[1] = 1.f;
    }
#pragma unroll
    for (int hp = 0; hp < 3; ++hp) {
      const int head = hp * 4 + (lane >> 4);
      if (head < 10) {
        const u16* src = qk + (size_t)t * 1280 + head * 128;
        const float* gg = head < 8 ? P.q_g1 : P.k_g1;
        const unsigned ua1 = *(const unsigned*)(src + 2 * i), ua2 = *(const unsigned*)(src + 32 + 2 * i);
        const unsigned ub1 = *(const unsigned*)(src + 64 + 2 * i), ub2 = *(const unsigned*)(src + 96 + 2 * i);
        float a1[2] = {bf_lo(ua1), bf_hi(ua1)}, a2[2] = {bf_lo(ua2), bf_hi(ua2)};
        float b1[2] = {bf_lo(ub1), bf_hi(ub1)}, b2[2] = {bf_lo(ub2), bf_hi(ub2)};
        float ss = a1[0] * a1[0] + a1[1] * a1[1] + a2[0] * a2[0] + a2[1] * a2[1] + b1[0] * b1[0] + b1[1] * b1[1] + b2[0] * b2[0] + b2[1] * b2[1];
        ss = sum16(ss);
        const float r = rsqrtf(ss * (1.f / 128.f) + EPS);
        float oa1[2], oa2[2], ob1[2], ob2[2];
#pragma unroll
        for (int e = 0; e < 2; ++e) {
          const float xa1 = a1[e] * r * gg[2 * i + e], xa2 = a2[e] * r * gg[32 + 2 * i + e];
          const float xb1 = b1[e] * r * gg[64 + 2 * i + e], xb2 = b2[e] * r * gg[96 + 2 * i + e];
          oa1[e] = xa1 * csr[e] - xa2 * snr[e]; oa2[e] = xa2 * csr[e] + xa1 * snr[e];
          ob1[e] = xb1 * csc[e] - xb2 * snc[e]; ob2[e] = xb2 * csc[e] + xb1 * snc[e];
        }
        if (head < 8) {
          constexpr float CQ = 0.08838834764831845f * 1.4426950408889634f;
#pragma unroll
          for (int e = 0; e < 2; ++e) { oa1[e] *= CQ; oa2[e] *= CQ; ob1[e] *= CQ; ob2[e] *= CQ; }
        }
        u16* dst = head < 8 ? Qo + (size_t)t * 1024 + head * 128 : Ko + (size_t)t * 256 + (head - 8) * 128;
        *(unsigned*)(dst + 2 * i) = cvtpk(oa1[0], oa1[1]);
        *(unsigned*)(dst + 32 + 2 * i) = cvtpk(oa2[0], oa2[1]);
        *(unsigned*)(dst + 64 + 2 * i) = cvtpk(ob1[0], ob1[1]);
        *(unsigned*)(dst + 96 + 2 * i) = cvtpk(ob2[0], ob2[1]);
      }
    }
  }
}

#define RAW_BAR() do { asm volatile("s_waitcnt lgkmcnt(0)" ::: "memory"); __builtin_amdgcn_s_barrier(); asm volatile("" ::: "memory"); } while (0)
DI float xhalf_max(float x) {
  auto rr = __builtin_amdgcn_permlane32_swap(__float_as_uint(x), __float_as_uint(x), false, false);
  return fmaxf(__uint_as_float(rr[0]), __uint_as_float(rr[1]));
}
DI float xhalf_sum(float x) {
  auto rr = __builtin_amdgcn_permlane32_swap(__float_as_uint(x), __float_as_uint(x), false, false);
  return __uint_as_float(rr[0]) + __uint_as_float(rr[1]);
}
template <int DQK, int NHQ, int NHKV, bool HAS_META>
DI void attn_phase(const u16* __restrict__ Q, const u16* __restrict__ K, const u16* __restrict__ Vt, u16* __restrict__ O, const float* __restrict__ qg, const float* __restrict__ kg, char* smem, const int wv) {
  constexpr int NS = DQK / 16, CH = DQK / 8, KSTR = DQK * 2 + 16, VSTR = 144;
  constexpr int KBYTES = 64 * KSTR, VBYTES = 128 * VSTR;
  constexpr int NKC = 64 * CH / NTHREADS;
  constexpr int NT = (L + 63) / 64;
  constexpr bool EARLY_FETCH = (DQK == 128);
  constexpr int LDK = NHKV * DQK;
  static_assert(2 * (KBYTES + VBYTES) <= SMEM_BYTES, "attention LDS");
  const int tid = otid(wv), lane = tid & 63, wave = __builtin_amdgcn_readfirstlane(tid >> 6), r32 = lane & 31, hh = lane >> 5, grp = wave >> 2;
  constexpr int NF = NSEQ * NHQ * 16, nItems = NF + (HAS_META ? NSEQ * NHQ : 0);
#define A_DECODE(it_, hq_, sq_, q0_, ql_) do { if ((it_) < NF) { hq_ = ((it_) >> 4) % NHQ; sq_ = (it_) / (16 * NHQ); q0_ = NMETA + 256 * ((it_) & 15); ql_ = L; } \
    else { const int tt_ = (it_) - NF; hq_ = tt_ % NHQ; sq_ = tt_ / NHQ; q0_ = 0; ql_ = NMETA; } } while (0)
  char* kb0 = smem; char* vb0 = smem + 2 * KBYTES;
  const int lkey = tid >> 3, lc8 = tid & 7;
  const unsigned koff = (unsigned)(lkey * LDK * 2 + lc8 * 16);
  const unsigned koffL = (unsigned)(min(lkey, 15) * LDK * 2 + lc8 * 16);
  const unsigned voff = (unsigned)((lkey * LP + lc8 * 8) * 2);
  const unsigned kwoff = (unsigned)(lkey * KSTR + lc8 * 16), vwoff = (unsigned)(lkey * VSTR + lc8 * 16);
  const int G_ = (int)gridDim.x, b_ = obid();
  int item = (G_ % 8 == 0) ? (b_ % 8) * (G_ / 8) + b_ / 8 : b_;
  if (item >= nItems) return;
  u32x4 rk[NKC], rv[2];
#define A_LOADK(Kb_, tile_) do { const char* kp_ = (const char*)(Kb_) + (size_t)(tile_) * (64 * LDK * 2); const unsigned ko_ = ((tile_) == NT - 1) ? koffL : koff; \
    _Pragma("unroll") for (int i_ = 0; i_ < NKC; ++i_) rk[i_] = *(const u32x4*)(kp_ + ko_ + i_ * 128); } while (0)
#define A_LOADV(Vb_, tile_) do { const char* vp_ = (const char*)(Vb_) + (size_t)(tile_) * 128; \
    rv[0] = *(const u32x4*)(vp_ + voff); rv[1] = *(const u32x4*)(vp_ + voff + 64 * LP * 2); } while (0)
#define A_WRITEK(bi_) do { char* b_ = kb0 + (bi_) * KBYTES + kwoff; \
    _Pragma("unroll") for (int i_ = 0; i_ < NKC; ++i_) *(u32x4*)(b_ + i_ * 128) = rk[i_]; } while (0)
#define A_WRITEV(bi_) do { char* b_ = vb0 + (bi_) * VBYTES + vwoff; \
    *(u32x4*)(b_) = rv[0]; *(u32x4*)(b_ + 64 * VSTR) = rv[1]; } while (0)
#define A_FETCH(j_) do { \
        if ((j_) + 3 < NT) A_LOADK(Kb, (j_) + 3); \
        else if ((j_) == NT - 3 && has_next) A_LOADK(nKb, 0); \
        else if ((j_) == NT - 1 && has_next) A_LOADK(nKb, 1); \
        if ((j_) + 2 < NT) A_LOADV(Vb, (j_) + 2); \
        else if ((j_) == NT - 2 && has_next) A_LOADV(nVb, 0); } while (0)
#define A_QK(bi_) do { const char* sk_ = kb0 + (bi_) * KBYTES + r32 * KSTR + hh * 16; \
    _Pragma("unroll") for (int i_ = 0; i_ < 16; ++i_) { s0[i_] = 0.f; s1[i_] = 0.f; } \
    _Pragma("unroll") for (int i_ = 0; i_ < NS; ++i_) { \
      const bf16x8 k0f_ = *(const bf16x8*)(sk_ + i_ * 32); const bf16x8 k1f_ = *(const bf16x8*)(sk_ + 32 * KSTR + i_ * 32); \
      s0 = __builtin_amdgcn_mfma_f32_32x32x16_bf16(k0f_, qf[i_], s0, 0, 0, 0); \
      s1 = __builtin_amdgcn_mfma_f32_32x32x16_bf16(k1f_, qf[i_], s1, 0, 0, 0); } } while (0)
  int hq, sq, q0, qlim;
  A_DECODE(item, hq, sq, q0, qlim);
  const u16* Kb = K + (size_t)(sq * L) * LDK + (hq / (NHQ / NHKV)) * DQK;
  const u16* Vb = Vt + (size_t)((sq * NHKV + hq / (NHQ / NHKV)) * 128) * LP;
  A_LOADK(Kb, 0); A_WRITEK(0); A_LOADK(Kb, 1); A_LOADV(Vb, 0);
  if (grp == 1) { RAW_BAR(); }
  RAW_BAR();
  float l;
  f32x16 o[4], s0, s1;
  bf16x8 qf[NS], pb[4];
  for (;;) {
    const int pq = q0 + wave * 32 + r32;
    const bool valid = pq < qlim;
    const bool active = (item < NF) || (wave == 0);
    {
      const u16* qrow = Q + (size_t)(sq * L + (valid ? pq : qlim - 1)) * (NHQ * DQK) + hq * DQK + hh * 8;
#pragma unroll
      for (int i = 0; i < NS; ++i) qf[i] = *(const bf16x8*)(qrow + 16 * i);
    }
    l = 0.f;
#pragma unroll
    for (int d = 0; d < 4; ++d)
#pragma unroll
      for (int i = 0; i < 16; ++i) o[d][i] = 0.f;
    const int nitem = item + (int)gridDim.x;
    const bool has_next = nitem < nItems;
    int nhq, nsq, nq0, nqlim;
    A_DECODE(nitem, nhq, nsq, nq0, nqlim);
    const u16* nKb = K + (size_t)(nsq * L) * LDK + (nhq / (NHQ / NHKV)) * DQK;
    const u16* nVb = Vt + (size_t)((nsq * NHKV + nhq / (NHQ / NHKV)) * 128) * LP;
    RAW_BAR();
    A_WRITEK(1); A_WRITEV(0);
    __builtin_amdgcn_sched_barrier(0);
    if (active) A_QK(0);
    __builtin_amdgcn_sched_barrier(0);
    A_LOADK(Kb, 2); A_LOADV(Vb, 1);
    RAW_BAR();
    for (int j = 0; j < NT; ++j) {
      __builtin_amdgcn_s_setprio(0);
      if (active) {
        f32x2 ps2 = {0.f, 0.f};
        unsigned w_[16];
#pragma unroll
        for (int i = 0; i < 8; ++i) {
          f32x2 v;
          v[0] = __builtin_amdgcn_exp2f(s0[2 * i]); v[1] = __builtin_amdgcn_exp2f(s0[2 * i + 1]);
          if (j == NT - 1 && i >= 4) v = f32x2{0.f, 0.f};
          ps2 += v;
          w_[i] = cvtpk(v[0], v[1]);
        }
#pragma unroll
        for (int i = 0; i < 8; ++i) {
          f32x2 v;
          v[0] = __builtin_amdgcn_exp2f(s1[2 * i]); v[1] = __builtin_amdgcn_exp2f(s1[2 * i + 1]);
          if (j == NT - 1) v = f32x2{0.f, 0.f};
          ps2 += v;
          w_[8 + i] = cvtpk(v[0], v[1]);
        }
        l += xhalf_sum(ps2[0] + ps2[1]);
        pb[0] = __builtin_bit_cast(bf16x8, u32x4{w_[0], w_[1], w_[2], w_[3]});
        pb[1] = __builtin_bit_cast(bf16x8, u32x4{w_[4], w_[5], w_[6], w_[7]});
        pb[2] = __builtin_bit_cast(bf16x8, u32x4{w_[8], w_[9], w_[10], w_[11]});
        pb[3] = __builtin_bit_cast(bf16x8, u32x4{w_[12], w_[13], w_[14], w_[15]});
      }
      __builtin_amdgcn_s_setprio(2);
      RAW_BAR();
      if (j + 2 < NT) A_WRITEK(j & 1);
      else if (j == NT - 1 && has_next) A_WRITEK(0);
      if (j + 1 < NT) A_WRITEV((j + 1) & 1);
      __builtin_amdgcn_sched_barrier(0);
      if constexpr (EARLY_FETCH) { A_FETCH(j); __builtin_amdgcn_sched_barrier(0); }
        if (active && j == NT - 1) {
        const char* svl = vb0 + (j & 1) * VBYTES + r32 * VSTR + hh * 16;
        bf16x8 vf[4];
#pragma unroll
        for (int d = 0; d < 4; ++d) vf[d] = *(const bf16x8*)(svl + d * 32 * VSTR);
#pragma unroll
        for (int d = 0; d < 4; ++d) o[d] = __builtin_amdgcn_mfma_f32_32x32x16_bf16(vf[d], pb[0], o[d], 0, 0, 0);
      } else if (active)
      {
        constexpr int NQK = 2 * NS, NM = NQK + 16, RING = (DQK == 128) ? 8 : 6;
        const char* sk = kb0 + ((j + 1) & 1) * KBYTES + r32 * KSTR + hh * 16;
        const char* sv = vb0 + (j & 1) * VBYTES + r32 * VSTR + hh * 16;
        bf16x8 ring[RING];
#define A_FRAG(dst_, i_) do { if ((i_) < NQK) { dst_ = *(const bf16x8*)(sk + ((i_) & 1) * (32 * KSTR) + ((i_) >> 1) * 32); } \
          else { dst_ = *(const bf16x8*)(sv + (((i_) - NQK) & 3) * (32 * VSTR) + (((i_) - NQK) >> 2) * 32); } } while (0)
#pragma unroll
        for (int i = 0; i < 16; ++i) { s0[i] = 0.f; s1[i] = 0.f; }
#pragma unroll
        for (int i = 0; i < RING; ++i) A_FRAG(ring[i], i);
#pragma unroll
        for (int i = 0; i < NM; ++i) {
          if (i < NQK) {
            if (i & 1) s1 = __builtin_amdgcn_mfma_f32_32x32x16_bf16(ring[i % RING], qf[i >> 1], s1, 0, 0, 0);
            else       s0 = __builtin_amdgcn_mfma_f32_32x32x16_bf16(ring[i % RING], qf[i >> 1], s0, 0, 0, 0);
          } else {
            o[(i - NQK) & 3] = __builtin_amdgcn_mfma_f32_32x32x16_bf16(ring[i % RING], pb[(i - NQK) >> 2], o[(i - NQK) & 3], 0, 0, 0);
          }
          if (i + RING < NM) A_FRAG(ring[i % RING], i + RING);
          __builtin_amdgcn_sched_barrier(0);
        }
#undef A_FRAG
      }
        __builtin_amdgcn_sched_barrier(0);
      if constexpr (!EARLY_FETCH) A_FETCH(j);
      if (j == NT - 1 && valid) {
        const float inv = 1.f / l;
        u16* orow = O + (size_t)(HAS_META ? sq * L + pq : sq * SEQ + pq - NMETA) * DM + hq * 128 + hh * 4;
#pragma unroll
        for (int d = 0; d < 4; ++d)
#pragma unroll
          for (int q = 0; q < 4; ++q) {
            u32x2 w = {cvtpk(o[d][4 * q] * inv, o[d][4 * q + 1] * inv), cvtpk(o[d][4 * q + 2] * inv, o[d][4 * q + 3] * inv)};
            *(u32x2*)(orow + d * 32 + q * 8) = w;
          }
      }
      RAW_BAR();
    }
    if (!has_next) break;
    item = nitem; hq = nhq; sq = nsq; q0 = nq0; qlim = nqlim; Kb = nKb; Vb = nVb;
  }
  __builtin_amdgcn_s_setprio(0);
  if (grp == 0) RAW_BAR();
  RAW_BAR();
#undef A_LOADK
#undef A_LOADV
#undef A_WRITEK
#undef A_WRITEV
#undef A_QK
#undef A_FETCH
#undef A_DECODE
}

template <int NHQ, int NHKV>
DI void attn_phase_l1(const u16* __restrict__ Q, const u16* __restrict__ K, const u16* __restrict__ Vt, u16* __restrict__ O, char* smem, const int wv) {
  constexpr int DQK = 128, NS = 8, KSTR = DQK * 2 + 16, VSTR = 144;
  constexpr int KBYTES = 64 * KSTR, VBYTES = 128 * VSTR;
  constexpr int NKC = 2;
  constexpr int NT = (L + 63) / 64;
  constexpr int LDK = NHKV * DQK;
  constexpr int NF = NSEQ * NHQ * 16;
  const int tid = otid(wv), lane = tid & 63, wave = __builtin_amdgcn_readfirstlane(tid >> 6), r32 = lane & 31, hh = lane >> 5;
  char* kb0 = smem; char* vb0 = smem + 2 * KBYTES;
  const int lkey = tid >> 3, lc8 = tid & 7;
  const unsigned koff = (unsigned)(lkey * LDK * 2 + lc8 * 16);
  const unsigned koffL = (unsigned)(min(lkey, 15) * LDK * 2 + lc8 * 16);
  const unsigned voff = (unsigned)((lkey * LP + lc8 * 8) * 2);
  const unsigned kwoff = (unsigned)(lkey * KSTR + lc8 * 16), vwoff = (unsigned)(lkey * VSTR + lc8 * 16);
  const int G_ = (int)gridDim.x, b_ = obid();
  u32x4 rk[NKC], rv[2];
#define B_LOADK(Kb_, tile_) do { const char* kp_ = (const char*)(Kb_) + (size_t)(tile_) * (64 * LDK * 2); const unsigned ko_ = ((tile_) == NT - 1) ? koffL : koff; \
    _Pragma("unroll") for (int i_ = 0; i_ < NKC; ++i_) rk[i_] = *(const u32x4*)(kp_ + ko_ + i_ * 128); } while (0)
#define B_LOADV(Vb_, tile_) do { const char* vp_ = (const char*)(Vb_) + (size_t)(tile_) * 128; \
    rv[0] = *(const u32x4*)(vp_ + voff); rv[1] = *(const u32x4*)(vp_ + voff + 64 * LP * 2); } while (0)
#define B_WRITEK(bi_) do { char* b_w = kb0 + (bi_) * KBYTES + kwoff; \
    _Pragma("unroll") for (int i_ = 0; i_ < NKC; ++i_) *(u32x4*)(b_w + i_ * 128) = rk[i_]; } while (0)
#define B_WRITEV(bi_) do { char* b_w = vb0 + (bi_) * VBYTES + vwoff; \
    *(u32x4*)(b_w) = rv[0]; *(u32x4*)(b_w + 64 * VSTR) = rv[1]; } while (0)
  f32x16 o[4], s0, s1;
  bf16x8 qf[NS], pb[4];
  for (int item = (G_ % 8 == 0) ? (b_ % 8) * (G_ / 8) + b_ / 8 : b_; item < NF; item += G_) {
    const int hq = (item >> 4) % NHQ, sq = item / (16 * NHQ), q0 = NMETA + 256 * (item & 15);
    const u16* Kb = K + (size_t)(sq * L) * LDK + (hq / (NHQ / NHKV)) * DQK;
    const u16* Vb = Vt + (size_t)((sq * NHKV + hq / (NHQ / NHKV)) * 128) * LP;
    const int pq = q0 + wave * 32 + r32;
    {
      const u16* qrow = Q + (size_t)(sq * L + pq) * (NHQ * DQK) + hq * DQK + hh * 8;
#pragma unroll
      for (int i = 0; i < NS; ++i) qf[i] = *(const bf16x8*)(qrow + 16 * i);
    }
    float l = 0.f;
#pragma unroll
    for (int d = 0; d < 4; ++d)
#pragma unroll
      for (int i = 0; i < 16; ++i) o[d][i] = 0.f;
    __syncthreads();
    B_LOADK(Kb, 0); B_WRITEK(0); B_LOADK(Kb, 1); B_WRITEK(1); B_LOADV(Vb, 0); B_WRITEV(0);
    B_LOADK(Kb, 2); B_LOADV(Vb, 1);
    __syncthreads();
    {
      const char* sk = kb0 + r32 * KSTR + hh * 16;
#pragma unroll
      for (int i = 0; i < 16; ++i) { s0[i] = 0.f; s1[i] = 0.f; }
#pragma unroll
      for (int i = 0; i < NS; ++i) {
        const bf16x8 k0f = *(const bf16x8*)(sk + i * 32), k1f = *(const bf16x8*)(sk + 32 * KSTR + i * 32);
        s0 = __builtin_amdgcn_mfma_f32_32x32x16_bf16(k0f, qf[i], s0, 0, 0, 0);
        s1 = __builtin_amdgcn_mfma_f32_32x32x16_bf16(k1f, qf[i], s1, 0, 0, 0);
      }
      unsigned w_[16]; f32x2 ps2 = {0.f, 0.f};
#pragma unroll
      for (int i = 0; i < 8; ++i) { f32x2 v; v[0] = __builtin_amdgcn_exp2f(s0[2 * i]); v[1] = __builtin_amdgcn_exp2f(s0[2 * i + 1]); ps2 += v; w_[i] = cvtpk(v[0], v[1]); }
#pragma unroll
      for (int i = 0; i < 8; ++i) { f32x2 v; v[0] = __builtin_amdgcn_exp2f(s1[2 * i]); v[1] = __builtin_amdgcn_exp2f(s1[2 * i + 1]); ps2 += v; w_[8 + i] = cvtpk(v[0], v[1]); }
      l += ps2[0] + ps2[1];
#pragma unroll
      for (int q = 0; q < 4; ++q) pb[q] = __builtin_bit_cast(bf16x8, u32x4{w_[4 * q], w_[4 * q + 1], w_[4 * q + 2], w_[4 * q + 3]});
    }
    asm volatile("s_waitcnt lgkmcnt(0)" ::: "memory"); __builtin_amdgcn_s_barrier(); asm volatile("" ::: "memory");
    for (int j = 0; j < NT; ++j) {
      if (j + 2 < NT) B_WRITEK(j & 1);
      if (j + 1 < NT) B_WRITEV((j + 1) & 1);
      __builtin_amdgcn_sched_barrier(0);
      if (j + 3 < NT) B_LOADK(Kb, j + 3);
      if (j + 2 < NT) B_LOADV(Vb, j + 2);
      __builtin_amdgcn_sched_barrier(0);
      if (j == NT - 1) {
        const char* svl = vb0 + (j & 1) * VBYTES + r32 * VSTR + hh * 16;
        bf16x8 vf[4];
#pragma unroll
        for (int d = 0; d < 4; ++d) vf[d] = *(const bf16x8*)(svl + d * 32 * VSTR);
#pragma unroll
        for (int d = 0; d < 4; ++d) o[d] = __builtin_amdgcn_mfma_f32_32x32x16_bf16(vf[d], pb[0], o[d], 0, 0, 0);
      } else {
        constexpr int NQK = 2 * NS, NM = NQK + 16, RING = 8;
        const char* sk = kb0 + ((j + 1) & 1) * KBYTES + r32 * KSTR + hh * 16;
        const char* sv = vb0 + (j & 1) * VBYTES + r32 * VSTR + hh * 16;
        bf16x8 ring[RING];
        unsigned w_[16]; f32x2 ps2 = {0.f, 0.f};
#define B_FRAG(dst_, i_) do { if ((i_) < NQK) { dst_ = *(const bf16x8*)(sk + ((i_) & 1) * (32 * KSTR) + ((i_) >> 1) * 32); } \
          else { dst_ = *(const bf16x8*)(sv + (((i_) - NQK) & 3) * (32 * VSTR) + (((i_) - NQK) >> 2) * 32); } } while (0)
#pragma unroll
        for (int i = 0; i < 16; ++i) { s0[i] = 0.f; s1[i] = 0.f; }
#pragma unroll
        for (int i = 0; i < RING; ++i) B_FRAG(ring[i], i);
#pragma unroll
        for (int i = 0; i < NM; ++i) {
          if (i < NQK) {
            if (i & 1) s1 = __builtin_amdgcn_mfma_f32_32x32x16_bf16(ring[i % RING], qf[i >> 1], s1, 0, 0, 0);
            else       s0 = __builtin_amdgcn_mfma_f32_32x32x16_bf16(ring[i % RING], qf[i >> 1], s0, 0, 0, 0);
          } else {
            o[(i - NQK) & 3] = __builtin_amdgcn_mfma_f32_32x32x16_bf16(ring[i % RING], pb[(i - NQK) >> 2], o[(i - NQK) & 3], 0, 0, 0);
          }
          if (i + RING < NM) B_FRAG(ring[i % RING], i + RING);
          if (i >= NQK + 2) {
            const int g = i - NQK - 2;
            f32x2 v;
            if (g < 8) { v[0] = __builtin_amdgcn_exp2f(s0[2 * g]); v[1] = __builtin_amdgcn_exp2f(s0[2 * g + 1]); }
            else       { v[0] = __builtin_amdgcn_exp2f(s1[2 * (g - 8)]); v[1] = __builtin_amdgcn_exp2f(s1[2 * (g - 8) + 1]); }
            ps2 += v; w_[g] = cvtpk(v[0], v[1]);
          }
          __builtin_amdgcn_sched_barrier(0);
        }
#pragma unroll
        for (int g = 14; g < 16; ++g) { f32x2 v; v[0] = __builtin_amdgcn_exp2f(s1[2 * (g - 8)]); v[1] = __builtin_amdgcn_exp2f(s1[2 * (g - 8) + 1]); ps2 += v; w_[g] = cvtpk(v[0], v[1]); }
#undef B_FRAG
        if (j + 1 == NT - 1) {
          ps2 = f32x2{0.f, 0.f};
#pragma unroll
          for (int g = 0; g < 4; ++g) { ps2[0] += __builtin_amdgcn_exp2f(s0[2 * g]); ps2[1] += __builtin_amdgcn_exp2f(s0[2 * g + 1]); }
#pragma unroll
          for (int g = 4; g < 16; ++g) w_[g] = 0u;
        }
        if (j + 1 < NT) {
          l += ps2[0] + ps2[1];
#pragma unroll
          for (int q = 0; q < 4; ++q) pb[q] = __builtin_bit_cast(bf16x8, u32x4{w_[4 * q], w_[4 * q + 1], w_[4 * q + 2], w_[4 * q + 3]});
        }
      }
      asm volatile("s_waitcnt lgkmcnt(0)" ::: "memory"); __builtin_amdgcn_s_barrier(); asm volatile("" ::: "memory");
    }
    {
      const float inv = 1.f / xhalf_sum(l);
      u16* orow = O + (size_t)(sq * SEQ + pq - NMETA) * DM + hq * 128 + hh * 4;
#pragma unroll
      for (int d = 0; d < 4; ++d)
#pragma unroll
        for (int q = 0; q < 4; ++q) {
          u32x2 w = {cvtpk(o[d][4 * q] * inv, o[d][4 * q + 1] * inv), cvtpk(o[d][4 * q + 2] * inv, o[d][4 * q + 3] * inv)};
          *(u32x2*)(orow + d * 32 + q * 8) = w;
        }
    }
  }
  __syncthreads();
#undef B_LOADK
#undef B_LOADV
#undef B_WRITEK
#undef B_WRITEV
}

#define XB_TMO      128
#define XB_XCNT(j)  (256  + 64 * (j))
#define XB_XSUB(j)  (1280 + 64 * (j))
#define XB_XGEN(j)  (2304 + 64 * (j))
#define XB_TOP      3328
#define XB_TOPGEN   3392
#define XCD_BAR_WORDS 3456
#define XB_SPIN_CAP (1u << 18)
#define LAS3 __attribute__((address_space(3)))
DI unsigned xb_ld(unsigned* p) { return __hip_atomic_load(p, __ATOMIC_RELAXED, __HIP_MEMORY_SCOPE_AGENT); }
DI unsigned xb_add(unsigned* p, unsigned v) { return __hip_atomic_fetch_add(p, v, __ATOMIC_RELAXED, __HIP_MEMORY_SCOPE_AGENT); }
DI unsigned xb_xcc_id() { return (unsigned)__builtin_amdgcn_s_getreg((3 << 11) | 20) & 0xFu; }
#define XB_SPIN(cond, bar) do { unsigned _sp = 0; while (cond) { __builtin_amdgcn_s_sleep(1); \
    if ((++_sp & 255u) == 0u) { if (xb_ld(&(bar)[XB_TMO])) break; if (_sp > XB_SPIN_CAP) { atomicAdd(&(bar)[XB_TMO], 1u); break; } } } } while (0)
struct XcdBarrier { unsigned* bar; unsigned x; volatile LAS3 unsigned* st; };
DI XcdBarrier xcd_barrier_post(unsigned* bar, volatile LAS3 unsigned* st) {
  XcdBarrier b; b.bar = bar; b.x = xb_xcc_id(); b.st = st;
  if (threadIdx.x == 0) (void)xb_add(&bar[XB_XCNT(b.x)], 1u);
  return b;
}
DI void xcd_barrier_complete(unsigned* bar, unsigned x, unsigned& nloc, unsigned& nx) {
  const unsigned G = gridDim.x * gridDim.y * gridDim.z;
  unsigned sum, cnt, mine, sp = 0u;
  for (;;) {
    sum = 0u; cnt = 0u; mine = 0u;
#pragma unroll
    for (unsigned j = 0; j < 16; ++j) { const unsigned c = xb_ld(&bar[XB_XCNT(j)]); sum += c; cnt += (c > 0u) ? 1u : 0u; mine = (j == x) ? c : mine; }
    if (sum == G) break;
    __builtin_amdgcn_s_sleep(1);
    if ((++sp & 255u) == 0u) { if (xb_ld(&bar[XB_TMO])) break; if (sp > XB_SPIN_CAP) { atomicAdd(&bar[XB_TMO], 1u); break; } }
  }
  nloc = mine > 0u ? mine : 1u; nx = cnt > 0u ? cnt : 1u;
}
DI void xcd_barrier(unsigned* bar, const unsigned x, volatile LAS3 unsigned* st) {
  asm volatile("s_waitcnt vmcnt(0)" ::: "memory");
  __syncthreads();
  if (threadIdx.x == 0) {
    __builtin_amdgcn_s_waitcnt(0);
    unsigned nloc = st[0], nx = st[1];
    if (nloc == 0u) { xcd_barrier_complete(bar, x, nloc, nx); st[0] = nloc; st[1] = nx; }
    const unsigned old = xb_add(&bar[XB_XSUB(x)], 1u);
    const unsigned gen = old / nloc;
    if (old + 1u == (gen + 1u) * nloc) {
      __builtin_amdgcn_fence(__ATOMIC_RELEASE, "agent");
      asm volatile("s_waitcnt vmcnt(0)" ::: "memory");
      const unsigned og = xb_add(&bar[XB_TOP], 1u);
      const unsigned tg = og / nx;
      if (og + 1u == (tg + 1u) * nx) xb_add(&bar[XB_TOPGEN], 1u);
      else XB_SPIN(xb_ld(&bar[XB_TOPGEN]) == tg, bar);
      __builtin_amdgcn_fence(__ATOMIC_ACQUIRE, "agent");
      xb_add(&bar[XB_XGEN(x)], 1u);
      asm volatile("s_waitcnt vmcnt(0)" ::: "memory");
    } else {
      XB_SPIN(xb_ld(&bar[XB_XGEN(x)]) == gen, bar);
      __builtin_amdgcn_fence(__ATOMIC_ACQUIRE, "agent");
      asm volatile("s_waitcnt vmcnt(0)" ::: "memory");
    }
  }
  __syncthreads();
}
constexpr size_t O_BAR = 47 * MiB + 512 * 1024;

template <class Tp> DI Tp* uni(Tp* p) {
  const unsigned long long v = (unsigned long long)p;
  const unsigned lo = __builtin_amdgcn_readfirstlane((unsigned)v), hi = __builtin_amdgcn_readfirstlane((unsigned)(v >> 32));
  typedef __attribute__((address_space(1))) Tp* gptr_t;
  return (Tp*)(gptr_t)(((unsigned long long)hi << 32) | lo);
}
DI Params ld_params() {
  const volatile __attribute__((address_space(4))) Params* kp = (const volatile __attribute__((address_space(4))) Params*)__builtin_amdgcn_kernarg_segment_ptr();
  Params r;
#define LDF(f_) r.f_ = uni(kp->f_)
  LDF(xp); LDF(xs); LDF(meta); LDF(mix_g); LDF(ffn_g); LDF(w_in); LDF(q_a_g); LDF(kv_a_g); LDF(w_uq); LDF(w_ukv); LDF(q_g0); LDF(k_g0);
  LDF(conv_w); LDF(w_out0); LDF(w_qkv); LDF(q_g1); LDF(k_g1); LDF(w_out1); LDF(w1); LDF(w3); LDF(w2); LDF(out); LDF(ws); LDF(hmeta);
#undef LDF
  return r;
}
constexpr size_t O_W = OFF_W, O_SS = 46 * MiB, O_R1 = OFF_R1, O_R2 = OFF_R2, O_R3 = OFF_R3, O_HBA = 800 * MiB;
constexpr size_t O_Z = O_R2, O_QPRE = O_R2, O_KNPRE = O_R2 + 145 * MiB, O_CQN = O_R3, O_CKVN = O_R3 + 73 * MiB, O_VT0 = O_R3 + 122 * MiB,
                 O_KR = O_R3 + 220 * MiB, O_ACT = O_R2, O_QKPRE = O_R2, O_VT1 = O_R3, O_Q1 = O_R3 + 49 * MiB, O_K1 = O_R3 + 242 * MiB;
constexpr size_t O_K0_IN_OUT = 145 * MiB;
#define WSP(P_, off_) ((u16*)((P_).ws + (off_)))
#define WW(P_, woff_) (WSP(P_, O_W) + (woff_))

__global__ void __launch_bounds__(NTHREADS) fwd_megakernel(Params Punused) {
  extern __shared__ __attribute__((aligned(16))) char smem[];
  cg::grid_group grid = cg::this_grid();
  const int wv = __builtin_amdgcn_readfirstlane((int)(threadIdx.x >> 6));
  volatile LAS3 unsigned* xst = (volatile LAS3 unsigned*)(smem + pg8::STAGE_BYTES);
  if (threadIdx.x < 4) xst[threadIdx.x] = 0u;
  __syncthreads();
  { const Params P = ld_params(); (void)xcd_barrier_post((unsigned*)(P.ws + O_BAR), xst); }
#define GRID_BAR() do { const Params Pb_ = ld_params(); xcd_barrier((unsigned*)(Pb_.ws + O_BAR), xb_xcc_id(), xst); } while (0)
  {
    const Params P = ld_params();
    u16* W = WSP(P, O_W);
    transpose_job(P.w_in, W + W_IN, 1024, IN0, 0, nullptr, wv);
    transpose_job(P.w_uq, W + W_UQ, 384, 768, 0, nullptr, wv);
    transpose_job(P.w_ukv, W + W_UKV, 256, 1024, 0, nullptr, wv);
    transpose_job(P.w_out0, W + W_OUT0, 1024, 1024, 0, nullptr, wv);
    transpose_job(P.w_qkv, W + W_QKV, 1024, 1536, 0, P.mix_g + DM, wv);
    transpose_job(P.w_out1, W + W_OUT1, 1024, 1024, 0, nullptr, wv);
    for (int l = 0; l < 2; ++l) {
      transpose_job(P.w1 + (size_t)l * 1024 * FFN, W + W_13 + (size_t)l * 5632 * 1024, 1024, FFN, 1, P.ffn_g + l * DM, wv);
      transpose_job(P.w3 + (size_t)l * 1024 * FFN, W + W_13 + (size_t)l * 5632 * 1024, 1024, FFN, 2, P.ffn_g + l * DM, wv);
      transpose_job(P.w2 + (size_t)l * 1024 * FFN, W + W_2 + (size_t)l * 1024 * FFN, FFN, 1024, 0, nullptr, wv);
    }
    norm_phase<true>(P, P.mix_g, WSP(P, O_R1), wv);
    float* ssq = (float*)(P.ws + O_SS);
    for (int i = obid() * NTHREADS + otid(wv); i < 3 * T; i += gridDim.x * NTHREADS) ssq[i] = 0.f;
  }
  grid.sync();
  { const Params P = ld_params();
    run_gemm(smem, WSP(P, O_R1), WW(P, W_IN), 2304, 1024, EpiStore{WSP(P, O_Z), IN0, IN0}, 0, wv); }
  GRID_BAR();
  { const Params P = ld_params();
    e1_phase(P, WSP(P, O_Z), WSP(P, O_CQN), WSP(P, O_CKVN), WSP(P, O_KR), WSP(P, O_R1), wv); }
  GRID_BAR();
  { const Params P = ld_params();
    run_gemm(smem, WSP(P, O_CQN), WW(P, W_UQ), 768, 384, EpiStore{WSP(P, O_QPRE), 768, 768}, 0, wv); }
  { const Params P = ld_params();
    run_gemm(smem, WSP(P, O_CKVN), WW(P, W_UKV), 1024, 256, EpiKV0{WSP(P, O_KNPRE), WSP(P, O_VT0)}, (int)gridDim.x - (3 * (TP / 256)) % (int)gridDim.x, wv); }
  GRID_BAR();
  { const Params P = ld_params();
    e2_phase(P, WSP(P, O_QPRE), WSP(P, O_KNPRE), WSP(P, O_KR), (u16*)P.out, (u16*)((char*)P.out + O_K0_IN_OUT), wv);
    zero_vt_pad(WSP(P, O_VT0), NSEQ * 4 * 128, wv); }
  GRID_BAR();
  { const Params P = ld_params();
    attn_phase<192, 4, 4, true>((const u16*)P.out, (const u16*)((char*)P.out + O_K0_IN_OUT), WSP(P, O_VT0), WSP(P, O_R1), P.q_g0, P.k_g0, smem, wv); }
  GRID_BAR();
  { const Params P = ld_params();
    run_gemm(smem, WSP(P, O_R1), WW(P, W_OUT0), 1024, 1024, EpiRes<0>{P, nullptr, WSP(P, O_HBA), (float*)(P.ws + O_SS)}, 0, wv); }
  GRID_BAR();
  { const Params P = ld_params();
    run_gemm(smem, WSP(P, O_HBA), WW(P, W_13), 5632, 1024, EpiSwiglu{WSP(P, O_ACT), (const float*)(P.ws + O_SS)}, 0, wv); }
  GRID_BAR();
  { const Params P = ld_params();
    run_gemm(smem, WSP(P, O_ACT), WW(P, W_2), 1024, FFN, EpiRes<1>{P, WSP(P, O_HBA), WSP(P, O_R1), (float*)(P.ws + O_SS) + T}, 0, wv); }
  GRID_BAR();
  { const Params P = ld_params();
    run_gemm(smem, WSP(P, O_R1), WW(P, W_QKV), 1536, 1024, EpiQKV1{WSP(P, O_QKPRE), WSP(P, O_VT1), (const float*)(P.ws + O_SS) + T}, 0, wv); }
  GRID_BAR();
  { const Params P = ld_params();
    e3_phase(P, WSP(P, O_QKPRE), WSP(P, O_Q1), WSP(P, O_K1), wv);
    zero_vt_pad(WSP(P, O_VT1), NSEQ * 2 * 128, wv); }
  GRID_BAR();
  { const Params P = ld_params();
    attn_phase_l1<8, 2>(WSP(P, O_Q1), WSP(P, O_K1), WSP(P, O_VT1), (u16*)P.out, smem, wv); }
  GRID_BAR();
  { const Params P = ld_params();
    run_gemm(smem, (const u16*)P.out, WW(P, W_OUT1), 1024, 1024, EpiRes<3>{P, WSP(P, O_R1), WSP(P, O_HBA), (float*)(P.ws + O_SS) + 2 * T}, 0, wv, TQ); }
  GRID_BAR();
  { const Params P = ld_params();
    run_gemm(smem, WSP(P, O_HBA), WW(P, W_13 + (size_t)5632 * 1024), 5632, 1024, EpiSwiglu{WSP(P, O_ACT), (const float*)(P.ws + O_SS) + 2 * T}, 0, wv, TQ); }
  GRID_BAR();
  { const Params P = ld_params();
    run_gemm(smem, WSP(P, O_ACT), WW(P, W_2 + (size_t)1024 * FFN), 1024, FFN, EpiRes<4>{P, WSP(P, O_HBA), nullptr, nullptr}, 0, wv, TQ); }
}

extern "C" void kernel_launch(void* const* d_in, const int* in_sizes, int n_in, void* d_out, int out_size, void* d_ws, size_t ws_size,
                              hipStream_t stream) {
  static int grid_blocks = 0;
  if (!grid_blocks) {
    if (hipFuncSetAttribute((const void*)fwd_megakernel, hipFuncAttributeMaxDynamicSharedMemorySize, SMEM_BYTES) != hipSuccess)
      fprintf(stderr, "kernel_launch: hipFuncSetAttribute failed\n");
    int dev = 0, cus = 0, per_cu = 0;
    hipGetDevice(&dev);
    hipDeviceGetAttribute(&cus, hipDeviceAttributeMultiprocessorCount, dev);
    if (hipOccupancyMaxActiveBlocksPerMultiprocessor(&per_cu, (const void*)fwd_megakernel, NTHREADS, SMEM_BYTES) != hipSuccess || per_cu < 1) per_cu = 1;
    (void)hipGetLastError();
    grid_blocks = cus * per_cu;
  }
  Params p;
  memset(&p, 0, sizeof(p));
  p.xp = (const float*)d_in[0]; p.xs = (const float*)d_in[1]; p.meta = (const float*)d_in[2]; p.mix_g = (const float*)d_in[3];
  p.ffn_g = (const float*)d_in[4]; p.w_in = (const float*)d_in[5]; p.q_a_g = (const float*)d_in[6]; p.kv_a_g = (const float*)d_in[7];
  p.w_uq = (const float*)d_in[8]; p.w_ukv = (const float*)d_in[9]; p.q_g0 = (const float*)d_in[10]; p.k_g0 = (const float*)d_in[11];
  p.conv_w = (const float*)d_in[12]; p.w_out0 = (const float*)d_in[13]; p.w_qkv = (const float*)d_in[14]; p.q_g1 = (const float*)d_in[15];
  p.k_g1 = (const float*)d_in[16]; p.w_out1 = (const float*)d_in[17]; p.w1 = (const float*)d_in[18]; p.w3 = (const float*)d_in[19];
  p.w2 = (const float*)d_in[20];
  p.out = (float*)d_out; p.ws = (char*)d_ws; p.hmeta = (float*)((char*)d_ws + OFF_HM);
  (void)hipMemsetAsync((char*)d_ws + O_BAR, 0, XCD_BAR_WORDS * sizeof(unsigned), stream);
  void* args[] = {&p};
  hipError_t e = hipLaunchCooperativeKernel((const void*)fwd_megakernel, dim3(grid_blocks), dim3(NTHREADS), args, SMEM_BYTES, stream);
  if (e != hipSuccess) fprintf(stderr, "cooperative launch failed: %s (grid %d)\n", hipGetErrorString(e), grid_blocks);
}
```

```cpp
#include <hip/hip_runtime.h>
#include <hip/hip_cooperative_groups.h>
#include <cstdio>
#include <cstring>
namespace cg = cooperative_groups;

#define DI __device__ __forceinline__
typedef unsigned short u16;
using bf16x8   = __attribute__((ext_vector_type(8))) short;
using f32x16   = __attribute__((ext_vector_type(16))) float;
using f32x4    = __attribute__((ext_vector_type(4))) float;
using f32x2    = __attribute__((ext_vector_type(2))) float;
using u32x4    = __attribute__((ext_vector_type(4))) unsigned;
using u32x2    = __attribute__((ext_vector_type(2))) unsigned;
using bf16x2_t = __attribute__((ext_vector_type(2))) __bf16;

constexpr int NTHREADS = 512;
constexpr int DM = 1024, NSEQ = 24, NMETA = 16, SEQ = 4096, L = SEQ + NMETA, LP = 4160, T = NSEQ * L;
constexpr int IN0 = 2240, FFN = 2816;
constexpr float EPS = 1e-6f;

constexpr size_t MiB = 1024 * 1024;
constexpr size_t OFF_W = 0, OFF_HM = 48 * MiB, OFF_R1 = 50 * MiB, OFF_R2 = 243 * MiB, OFF_R3 = 665 * MiB;
constexpr size_t W_IN = 0, W_UQ = W_IN + (size_t)2304 * 1024, W_UKV = W_UQ + 768 * 384, W_OUT0 = W_UKV + 1024 * 256,
                 W_QKV = W_OUT0 + 1024 * 1024, W_OUT1 = W_QKV + 1536 * 1024, W_13 = W_OUT1 + 1024 * 1024,
                 W_2 = W_13 + 2 * (size_t)5632 * 1024, W_END = W_2 + 2 * (size_t)1024 * FFN;
static_assert(W_END * 2 <= 48 * MiB, "weights region");

struct Params {
  const float *xp, *xs, *meta, *mix_g, *ffn_g, *w_in, *q_a_g, *kv_a_g, *w_uq, *w_ukv, *q_g0, *k_g0, *conv_w, *w_out0,
      *w_qkv, *q_g1, *k_g1, *w_out1, *w1, *w3, *w2;
  float* out;
  char* ws;
  float* hmeta;
};

DI unsigned cvtpk(float lo, float hi) { f32x2 v = {lo, hi}; return __builtin_bit_cast(unsigned, __builtin_convertvector(v, bf16x2_t)); }
DI float bf_lo(unsigned u) { return __uint_as_float(u << 16); }
DI float bf_hi(unsigned u) { return __uint_as_float(u & 0xffff0000u); }
DI u16 f2bf(float x) { return (u16)(cvtpk(x, 0.f) & 0xffffu); }
DI int obid() { int b = blockIdx.x; asm volatile("" : "+s"(b)); return b; }
DI int otid(int wv) { int t; asm volatile("v_mbcnt_lo_u32_b32 %0, -1, 0\n\tv_mbcnt_hi_u32_b32 %0, -1, %0\n\tv_lshl_or_b32 %0, %1, 6, %0" : "=&v"(t) : "s"(wv)); return t; }
DI float wave_sum(float v) {
#pragma unroll
  for (int o = 32; o; o >>= 1) v += __shfl_xor(v, o);
  return v;
}
DI float sum16(float v) {
#pragma unroll
  for (int o = 8; o; o >>= 1) v += __shfl_xor(v, o);
  return v;
}
DI void unpack8(u32x4 v, float* f) {
#pragma unroll
  for (int i = 0; i < 4; ++i) { f[2 * i] = bf_lo(v[i]); f[2 * i + 1] = bf_hi(v[i]); }
}
DI u32x4 pack8(const float* f) { return u32x4{cvtpk(f[0], f[1]), cvtpk(f[2], f[3]), cvtpk(f[4], f[5]), cvtpk(f[6], f[7])}; }

DI const float* xrow(const Params& P, int t) {
  int s = t / L, p = t - s * L;
  if (p < NMETA) return P.meta + p * DM;
  const float* base = s < 8 ? P.xp + (size_t)(s * SEQ) * DM : P.xs + (size_t)((s - 8) * SEQ) * DM;
  return base + (size_t)(p - NMETA) * DM;
}
DI float* hrow(const Params& P, int t) {
  int s = t / L, p = t - s * L;
  if (p < NMETA) return P.hmeta + (s * NMETA + p) * DM;
  return P.out + ((size_t)s * SEQ + (p - NMETA)) * DM;
}

DI void transpose_job(const float* __restrict__ src, u16* __restrict__ dst, int K, int N, int mode, const float* __restrict__ gain, const int wv) {
  const int tid = otid(wv), lane = tid & 63, wave = tid >> 6;
  const int nkb = K / 32, nnb = N / 64;
  for (int ti = obid() * 8 + wave; ti < nkb * nnb; ti += gridDim.x * 8) {
    const int kb = ti / nnb, nb = ti - kb * nnb;
    const float* sp = src + (size_t)(kb * 32) * N + nb * 64 + lane;
    float v[32];
#pragma unroll
    for (int kk = 0; kk < 32; ++kk) v[kk] = sp[(size_t)kk * N];
    if (gain) {
#pragma unroll
      for (int kk = 0; kk < 32; ++kk) v[kk] *= gain[kb * 32 + kk];
    }
    const int n = nb * 64 + lane;
    int drow;
    if (mode == 4) {
      if (n < 1216) drow = n;
      else { const int c = (n - 1216) & 511, isu = (n >= 1728); drow = 1280 + (c >> 7) * 256 + isu * 128 + (c & 127); }
    } else drow = mode ? (n >> 7) * 256 + (mode - 1) * 128 + (n & 127) : n;
    u16* dp = dst + (size_t)drow * K + kb * 32;
#pragma unroll
    for (int q = 0; q < 4; ++q) *(u32x4*)(dp + q * 8) = pack8(&v[q * 8]);
  }
}

template <bool FROMX>
DI void norm_phase(const Params& P, const float* __restrict__ g, u16* __restrict__ hn, const int wv) {
  const int tid_ = otid(wv), wave = tid_ >> 6, lane = tid_ & 63;
  for (int t = obid() * 8 + wave; t < T; t += gridDim.x * 8) {
    const float* r = xrow(P, t);
    f32x4 v[4];
    float ss = 0.f;
#pragma unroll
    for (int j = 0; j < 4; ++j) {
      v[j] = *(const f32x4*)(r + j * 256 + lane * 4);
      ss += v[j][0] * v[j][0] + v[j][1] * v[j][1] + v[j][2] * v[j][2] + v[j][3] * v[j][3];
    }
    ss = wave_sum(ss);
    const float rs = rsqrtf(ss * (1.f / DM) + EPS);
#pragma unroll
    for (int j = 0; j < 4; ++j) {
      const f32x4 gg = *(const f32x4*)(g + j * 256 + lane * 4);
      u32x2 o = {cvtpk(v[j][0] * rs * gg[0], v[j][1] * rs * gg[1]), cvtpk(v[j][2] * rs * gg[2], v[j][3] * rs * gg[3])};
      *(u32x2*)(hn + (size_t)t * DM + j * 256 + lane * 4) = o;
    }
  }
}

namespace pg8 {
#define PG8_LAS __attribute__((address_space(3)))
constexpr int BM = 256, BKK = 64, HALF = 128, HTB = HALF * BKK * 2, STAGE_BYTES = 8 * HTB, NXCD = 8, WGM = 8;
DI int lds_byte(int r, int c) { const int st = (r >> 4) * 2 + (c >> 5), rr = r & 15, cc = c & 31, ob = rr * 64 + cc * 2; return st * 1024 + (ob ^ (((ob >> 9) & 1) << 5)); }
DI void stage_rc(int b, int& R, int& C) { const int st = b / 1024, sb = b % 1024, swz = sb ^ (((sb >> 9) & 1) << 5); R = (st >> 1) * 16 + swz / 64; C = (st & 1) * 32 + (swz % 64) / 2; }
DI int perm32(int rho) { const int n = rho >> 4, i = rho & 15; return 8 * (i >> 2) + 4 * n + (i & 3); }
struct Unit { int pm, pn; };
struct Gemm { const u16* A; const u16* Bt; int M, N, K; };
struct StaticOrder {
  int nM, nN, nwg, G, c;
  DI void init(int M, int N, int G_, int c_) { nM = M / BM; nN = N / BM; nwg = nM * nN; G = G_; c = c_; }
  DI bool next(int i, Unit& u) const {
    const long Lx = (long)i * G + c; if (__builtin_amdgcn_readfirstlane((int)(Lx >= nwg))) return false;
    int wgid = (int)Lx; { const int q = nwg / NXCD, r = nwg % NXCD, xcd = wgid % NXCD, off = wgid / NXCD; wgid = (xcd < r ? xcd * (q + 1) : r * (q + 1) + (xcd - r) * q) + off; }
    const int nig = WGM * nN, gid = wgid / nig, fm = gid * WGM, gsz = (nM - fm) < WGM ? (nM - fm) : WGM;
    u.pm = __builtin_amdgcn_readfirstlane(fm + ((wgid % nig) % gsz)); u.pn = __builtin_amdgcn_readfirstlane((wgid % nig) / gsz); return true;
  }
};
template <class Epi>
DI void gemm_phase(PG8_LAS unsigned char* lds, const Gemm g, const StaticOrder& S, const Epi& E, const int wv) {
  const int tid = otid(wv), wid = __builtin_amdgcn_readfirstlane(tid >> 6), lane = tid & 63, wr = wid >> 2, wc = wid & 3, fr = lane & 15, fq = lane >> 4;
  const int K = g.K, nt = K / BKK;
  unsigned voffA[2], voffB[2];
#pragma unroll
  for (int i = 0; i < 2; ++i) { int R, C; stage_rc(tid * 16 + i * 8192, R, C); const int Rb = (R & ~31) + perm32(R & 31);
    voffA[i] = (unsigned)(R * K + C) * 2u; voffB[i] = (unsigned)(Rb * K + C) * 2u; }
  const size_t kstep = (size_t)(BKK * 2);
  const size_t hstep = (size_t)HALF * K * 2;
  const size_t tstep = 2 * hstep;
  const unsigned ldsw = (unsigned)wid * 1024u;
  const int aoff = lds_byte(wr * 64 + fr, fq * 8), boff = lds_byte(wc * 32 + fr, fq * 8);
#define PG8_SA(b, h) (((b) * 2 + (h)) * HTB)
#define PG8_SB(b, h) ((4 + (b) * 2 + (h)) * HTB)
#define PG8_STAGE(bufoff, gbase, voff) do { _Pragma("unroll") for (int _i = 0; _i < 2; ++_i) \
    __builtin_amdgcn_global_load_lds((const unsigned*)((const char*)(gbase) + (voff)[_i]), (PG8_LAS unsigned*)(lds + (bufoff) + ldsw + _i * 8192), 16, 0, 0); } while (0)
#define PG8_LDA(dst, b, h) do { _Pragma("unroll") for (int m = 0; m < 4; ++m) _Pragma("unroll") for (int k = 0; k < 2; ++k) dst[m][k] = *(const PG8_LAS bf16x8*)(lds + PG8_SA(b, h) + aoff + m * 2048 + k * 1024); } while (0)
#define PG8_LDB(dst, b, h) do { _Pragma("unroll") for (int n = 0; n < 2; ++n) _Pragma("unroll") for (int k = 0; k < 2; ++k) dst[n][k] = *(const PG8_LAS bf16x8*)(lds + PG8_SB(b, h) + boff + n * 2048 + k * 1024); } while (0)
#define PG8_MMA(ai, bj, At, Bt) do { __builtin_amdgcn_s_setprio(1); _Pragma("unroll") for (int m = 0; m < 4; ++m) _Pragma("unroll") for (int n = 0; n < 2; ++n) _Pragma("unroll") for (int k = 0; k < 2; ++k) \
    acc[ai][bj][m][n] = __builtin_amdgcn_mfma_f32_16x16x32_bf16(Bt[n][k], At[m][k], acc[ai][bj][m][n], 0, 0, 0); __builtin_amdgcn_s_setprio(0); } while (0)
#define PG8_WAIT_V(n) asm volatile("s_waitcnt vmcnt(" #n ")" ::: "memory")
#define PG8_WAIT_L(n) asm volatile("s_waitcnt lgkmcnt(" #n ")" ::: "memory")
#define PG8_BAR __builtin_amdgcn_s_barrier()
#define PG8_SCHED __builtin_amdgcn_sched_barrier(0)
  Unit cur, nxt; int ui = 0;
  if (!S.next(0, cur)) return;
  f32x4 acc[2][2][4][2];
#pragma unroll
  for (int a = 0; a < 2; ++a)
#pragma unroll
    for (int b = 0; b < 2; ++b)
#pragma unroll
      for (int m = 0; m < 4; ++m)
#pragma unroll
        for (int n = 0; n < 2; ++n) acc[a][b][m][n] = (f32x4){0.f, 0.f, 0.f, 0.f};
  bf16x8 At[4][2], B0[2][2], B1[2][2];
  const char* cA = (const char*)g.A + (size_t)cur.pm * tstep; const char* cB = (const char*)g.Bt + (size_t)cur.pn * tstep;
  PG8_STAGE(PG8_SB(0, 0), cB, voffB); PG8_STAGE(PG8_SA(0, 0), cA, voffA); PG8_STAGE(PG8_SB(0, 1), cB + hstep, voffB); PG8_STAGE(PG8_SA(0, 1), cA + hstep, voffA);
  if (wr == 1) PG8_BAR;
  PG8_WAIT_V(4); PG8_BAR;
  PG8_STAGE(PG8_SB(1, 0), cB + kstep, voffB); PG8_STAGE(PG8_SA(1, 0), cA + kstep, voffA); PG8_STAGE(PG8_SB(1, 1), cB + hstep + kstep, voffB);
  PG8_WAIT_V(6); PG8_BAR;
  for (;;) {
    const bool has_next = S.next(ui + 1, nxt);
    const char* nA = has_next ? (const char*)g.A + (size_t)nxt.pm * tstep : cA; const char* nB = has_next ? (const char*)g.Bt + (size_t)nxt.pn * tstep : cB;
#pragma nounroll
    for (int t = 0; t < nt; t += 2) {
      const bool last = (t == nt - 2);
      const char* a1 = cA + (size_t)(t + 1) * kstep;
      const char* a2 = last ? nA : cA + (size_t)(t + 2) * kstep; const char* b2 = last ? nB : cB + (size_t)(t + 2) * kstep;
      const char* a3 = a2 + kstep; const char* b3 = b2 + kstep;
      PG8_LDB(B0, 0, 0); PG8_SCHED; PG8_LDA(At, 0, 0); PG8_STAGE(PG8_SA(1, 1), a1 + hstep, voffA);
      PG8_WAIT_L(8); PG8_BAR; PG8_WAIT_L(0); PG8_MMA(0, 0, At, B0); PG8_BAR; PG8_SCHED;
      PG8_LDB(B1, 0, 1); PG8_STAGE(PG8_SB(0, 0), b2, voffB);
      PG8_BAR; PG8_WAIT_L(0); PG8_MMA(0, 1, At, B1); PG8_BAR;
      PG8_LDA(At, 0, 1); PG8_STAGE(PG8_SA(0, 0), a2, voffA);
      PG8_BAR; PG8_WAIT_L(0); PG8_MMA(1, 0, At, B0); PG8_BAR; PG8_SCHED;
      PG8_STAGE(PG8_SB(0, 1), b2 + hstep, voffB);
      PG8_WAIT_V(6); PG8_BAR; PG8_MMA(1, 1, At, B1); PG8_BAR;
      PG8_LDB(B0, 1, 0); PG8_SCHED; PG8_LDA(At, 1, 0); PG8_STAGE(PG8_SA(0, 1), a2 + hstep, voffA);
      PG8_WAIT_L(8); PG8_BAR; PG8_WAIT_L(0); PG8_MMA(0, 0, At, B0); PG8_BAR; PG8_SCHED;
      PG8_LDB(B1, 1, 1); PG8_STAGE(PG8_SB(1, 0), b3, voffB);
      PG8_BAR; PG8_WAIT_L(0); PG8_MMA(0, 1, At, B1); PG8_BAR;
      PG8_LDA(At, 1, 1); PG8_STAGE(PG8_SA(1, 0), a3, voffA);
      PG8_BAR; PG8_WAIT_L(0); PG8_MMA(1, 0, At, B0); PG8_BAR; PG8_SCHED;
      PG8_STAGE(PG8_SB(1, 1), b3 + hstep, voffB);
      PG8_WAIT_V(6); PG8_BAR; PG8_MMA(1, 1, At, B1); PG8_BAR;
    }
    E(acc, cur, wr, wc, fr, fq);
    if (!has_next) break;
#pragma unroll
    for (int a = 0; a < 2; ++a)
#pragma unroll
      for (int b = 0; b < 2; ++b)
#pragma unroll
        for (int m = 0; m < 4; ++m)
#pragma unroll
          for (int n = 0; n < 2; ++n) acc[a][b][m][n] = (f32x4){0.f, 0.f, 0.f, 0.f};
    cur = nxt; cA = nA; cB = nB; ++ui;
  }
  PG8_WAIT_V(0);
  if (wr == 0) PG8_BAR;
  PG8_BAR;
#undef PG8_SA
#undef PG8_SB
#undef PG8_STAGE
#undef PG8_LDA
#undef PG8_LDB
#undef PG8_MMA
#undef PG8_WAIT_V
#undef PG8_WAIT_L
#undef PG8_BAR
#undef PG8_SCHED
}
}

constexpr int TQ = NSEQ * SEQ;
constexpr int TP = 98816;
constexpr int SMEM_BYTES = pg8::STAGE_BYTES + 16;
typedef const f32x4 (&AccRef)[2][2][4][2];
DI u32x4 pack8v(f32x4 a, f32x4 b) { return u32x4{cvtpk(a[0], a[1]), cvtpk(a[2], a[3]), cvtpk(b[0], b[1]), cvtpk(b[2], b[3])}; }

DI int vt_pos(int p) { return (p & ~12) | ((p & 4) << 1) | ((p & 8) >> 1); }
#define EPI_ROWS_BEGIN() \
  _Pragma("unroll") for (int ai = 0; ai < 2; ++ai) { if (u.pm * 256 + ai * 128 >= T) continue;
#define EPI_ROWS_END() }

struct EpiStore {
  u16* out; int ldc; int nvalid;
  DI void operator()(AccRef acc, const pg8::Unit& u, int wr, int wc, int fr, int fq) const {
    const int row0 = u.pm * 256 + wr * 64 + fr, col0 = u.pn * 256 + wc * 32 + 8 * fq;
    EPI_ROWS_BEGIN()
#pragma unroll
      for (int m = 0; m < 4; ++m) {
        u16* rp = out + (size_t)(row0 + ai * 128 + m * 16) * ldc + col0;
#pragma unroll
        for (int bj = 0; bj < 2; ++bj)
          if (col0 + bj * 128 < nvalid) *(u32x4*)(rp + bj * 128) = pack8v(acc[ai][bj][m][0], acc[ai][bj][m][1]);
      }
    EPI_ROWS_END()
  }
};
constexpr int ZLD = 1728;
struct EpiZ {
  u16* z;
  DI void operator()(AccRef acc, const pg8::Unit& u, int wr, int wc, int fr, int fq) const {
    const int row0 = u.pm * 256 + wr * 64 + fr;
    EPI_ROWS_BEGIN()
#pragma unroll
      for (int m = 0; m < 4; ++m) {
        u16* rp = z + (size_t)(row0 + ai * 128 + m * 16) * ZLD;
        if (u.pn < 5) {
          const int col0 = u.pn * 256 + wc * 32 + 8 * fq;
#pragma unroll
          for (int bj = 0; bj < 2; ++bj)
            if (col0 + bj * 128 < 1216) *(u32x4*)(rp + col0 + bj * 128) = pack8v(acc[ai][bj][m][0], acc[ai][bj][m][1]);
        } else {
          const int col0 = 1216 + (u.pn - 5) * 128 + wc * 32 + 8 * fq;
          *(u32x4*)(rp + col0) = pack8v(acc[ai][0][m][0] * acc[ai][1][m][0], acc[ai][0][m][1] * acc[ai][1][m][1]);
        }
      }
    EPI_ROWS_END()
  }
};
struct EpiKV0 {
  u16* kn; u16* vt;
  DI void operator()(AccRef acc, const pg8::Unit& u, int wr, int wc, int fr, int fq) const {
    const int row0 = u.pm * 256 + wr * 64 + fr, w0 = wc * 32 + 8 * fq, head = u.pn;
    EPI_ROWS_BEGIN()
#pragma unroll
      for (int m = 0; m < 4; ++m) {
        const int row = row0 + ai * 128 + m * 16;
        const int s = row / L, p = row - s * L;
        *(u32x4*)(kn + (size_t)row * 512 + head * 128 + w0) = pack8v(acc[ai][0][m][0], acc[ai][0][m][1]);
        u16* vp = vt + (size_t)((s * 4 + head) * 128 + w0) * LP + vt_pos(p);
#pragma unroll
        for (int n = 0; n < 2; ++n)
#pragma unroll
          for (int e = 0; e < 4; ++e) vp[(size_t)(4 * n + e) * LP] = f2bf(acc[ai][1][m][n][e]);
        asm volatile("" ::: "memory");
      }
    EPI_ROWS_END()
  }
};
struct EpiQKV1 {
  u16* qk; u16* vt; const float* ss;
  DI void operator()(AccRef acc, const pg8::Unit& u, int wr, int wc, int fr, int fq) const {
    const int row0 = u.pm * 256 + wr * 64 + fr, w0 = wc * 32 + 8 * fq;
    EPI_ROWS_BEGIN()
      float rs[4];
#pragma unroll
      for (int m = 0; m < 4; ++m) rs[m] = ss[row0 + ai * 128 + m * 16];
#pragma unroll
      for (int m = 0; m < 4; ++m) rs[m] = rsqrtf(rs[m] * (1.f / DM) + EPS);
#pragma unroll
      for (int m = 0; m < 4; ++m) {
        const int row = row0 + ai * 128 + m * 16;
        if (u.pn < 5) {
#pragma unroll
          for (int bj = 0; bj < 2; ++bj)
            *(u32x4*)(qk + (size_t)row * 1280 + u.pn * 256 + bj * 128 + w0) = pack8v(acc[ai][bj][m][0] * rs[m], acc[ai][bj][m][1] * rs[m]);
        } else {
          const int s = row / L, p = row - s * L;
#pragma unroll
          for (int bj = 0; bj < 2; ++bj) {
            u16* vp = vt + (size_t)((s * 2 + bj) * 128 + w0) * LP + vt_pos(p);
#pragma unroll
            for (int n = 0; n < 2; ++n)
#pragma unroll
              for (int e = 0; e < 4; ++e) vp[(size_t)(4 * n + e) * LP] = f2bf(acc[ai][bj][m][n][e] * rs[m]);
          }
          asm volatile("" ::: "memory");
        }
      }
    EPI_ROWS_END()
  }
};
template <int MODE>
struct EpiRes {
  Params P; const u16* hsrc; u16* hdst; float* ss;
  DI void operator()(AccRef acc, const pg8::Unit& u, int wr, int wc, int fr, int fq) const {
    const int row0 = u.pm * 256 + wr * 64 + fr, col0 = u.pn * 256 + wc * 32 + 8 * fq;
    EPI_ROWS_BEGIN()
      f32x4 r[4][2][2];
      if constexpr (MODE == 0) {
#pragma unroll
        for (int m = 0; m < 4; ++m) {
          const float* src = xrow(P, row0 + ai * 128 + m * 16) + col0;
#pragma unroll
          for (int bj = 0; bj < 2; ++bj) { r[m][bj][0] = *(const f32x4*)(src + bj * 128); r[m][bj][1] = *(const f32x4*)(src + bj * 128 + 4); }
        }
      } else {
        u32x4 rb[4][2];
#pragma unroll
        for (int m = 0; m < 4; ++m)
#pragma unroll
          for (int bj = 0; bj < 2; ++bj) {
            const int rr = row0 + ai * 128 + m * 16;
            const int sr = (MODE == 3) ? rr + NMETA * ((rr >> 12) + 1) : rr;
            rb[m][bj] = *(const u32x4*)(hsrc + (size_t)sr * DM + col0 + bj * 128);
          }
#pragma unroll
        for (int m = 0; m < 4; ++m)
#pragma unroll
          for (int bj = 0; bj < 2; ++bj) {
            r[m][bj][0] = f32x4{bf_lo(rb[m][bj][0]), bf_hi(rb[m][bj][0]), bf_lo(rb[m][bj][1]), bf_hi(rb[m][bj][1])};
            r[m][bj][1] = f32x4{bf_lo(rb[m][bj][2]), bf_hi(rb[m][bj][2]), bf_lo(rb[m][bj][3]), bf_hi(rb[m][bj][3])};
          }
      }
#pragma unroll
      for (int m = 0; m < 4; ++m) {
        const int row = row0 + ai * 128 + m * 16;
        if constexpr (MODE == 4) {
          float* dst = P.out + (size_t)row * DM + col0;
#pragma unroll
          for (int bj = 0; bj < 2; ++bj) {
            *(f32x4*)(dst + bj * 128) = r[m][bj][0] + acc[ai][bj][m][0];
            *(f32x4*)(dst + bj * 128 + 4) = r[m][bj][1] + acc[ai][bj][m][1];
          }
        } else if constexpr (MODE == 2) {
          const int s = row / L, p = row - s * L;
          if (p >= NMETA) {
            float* dst = P.out + ((size_t)s * SEQ + (p - NMETA)) * DM + col0;
#pragma unroll
            for (int bj = 0; bj < 2; ++bj) {
              *(f32x4*)(dst + bj * 128) = r[m][bj][0] + acc[ai][bj][m][0];
              *(f32x4*)(dst + bj * 128 + 4) = r[m][bj][1] + acc[ai][bj][m][1];
            }
          }
        } else {
          float s2 = 0.f;
#pragma unroll
          for (int bj = 0; bj < 2; ++bj) {
            const f32x4 r0 = r[m][bj][0] + acc[ai][bj][m][0], r1 = r[m][bj][1] + acc[ai][bj][m][1];
            *(u32x4*)(hdst + (size_t)row * DM + col0 + bj * 128) = pack8v(r0, r1);
            s2 += r0[0] * r0[0] + r0[1] * r0[1] + r0[2] * r0[2] + r0[3] * r0[3] + r1[0] * r1[0] + r1[1] * r1[1] + r1[2] * r1[2] + r1[3] * r1[3];
          }
          s2 += __shfl_xor(s2, 16);
          s2 += __shfl_xor(s2, 32);
          if (fq == 0) atomicAdd(ss + row, s2);
        }
      }
    EPI_ROWS_END()
  }
};
struct EpiSwiglu {
  u16* act; const float* ss;
  DI void operator()(AccRef acc, const pg8::Unit& u, int wr, int wc, int fr, int fq) const {
    const int row0 = u.pm * 256 + wr * 64 + fr, col0 = u.pn * 128 + wc * 32 + 8 * fq;
    EPI_ROWS_BEGIN()
      float rs[4];
#pragma unroll
      for (int m = 0; m < 4; ++m) rs[m] = ss[row0 + ai * 128 + m * 16];
#pragma unroll
      for (int m = 0; m < 4; ++m) rs[m] = rsqrtf(rs[m] * (1.f / DM) + EPS);
#pragma unroll
      for (int m = 0; m < 4; ++m) {
        const int row = row0 + ai * 128 + m * 16;
        const float ne = rs[m] * -1.4426950408889634f, r2 = rs[m] * rs[m];
        f32x4 y[2];
#pragma unroll
        for (int n = 0; n < 2; ++n)
#pragma unroll
          for (int e = 0; e < 4; ++e) {
            const float a = acc[ai][0][m][n][e], b = acc[ai][1][m][n][e];
            y[n][e] = a * b * r2 * __builtin_amdgcn_rcpf(1.f + __builtin_amdgcn_exp2f(a * ne));
          }
        *(u32x4*)(act + (size_t)row * FFN + col0) = pack8v(y[0], y[1]);
      }
    EPI_ROWS_END()
  }
};
template <class Epi>
DI void run_gemm(char* smem, const u16* A, const u16* Bt, int N, int K, const Epi& E, int shift, const int wv, const int M = TP) {
  pg8::Gemm g{A, Bt, M, N, K};
  pg8::StaticOrder S; S.init(M, N, (int)gridDim.x, (int)((obid() + shift) % gridDim.x));
  pg8::gemm_phase<Epi>((PG8_LAS unsigned char*)smem, g, S, E, wv);
}

DI void e1_phase(const Params& P, const u16* __restrict__ z, u16* __restrict__ cqn, u16* __restrict__ ckvn, u16* __restrict__ kr,
                 u16* __restrict__ mix, const int wv) {
  const int tid_ = otid(wv), wave = tid_ >> 6, lane = tid_ & 63;
  for (int t = obid() * 8 + wave; t < T; t += gridDim.x * 8) {
    const u16* zr = z + (size_t)t * ZLD;
    const int s = t / L, p = t - s * L;
    float f[8], o[8];
    {
      float ss = 0.f;
      if (lane < 48) { unpack8(*(const u32x4*)(zr + lane * 8), f);
#pragma unroll
        for (int e = 0; e < 8; ++e) ss += f[e] * f[e]; }
      ss = wave_sum(ss);
      const float r = rsqrtf(ss * (1.f / 384.f) + EPS);
      if (lane < 48) {
#pragma unroll
        for (int e = 0; e < 8; ++e) o[e] = f[e] * r * P.q_a_g[lane * 8 + e];
        *(u32x4*)(cqn + (size_t)t * 384 + lane * 8) = pack8(o);
      }
    }
    {
      float ss = 0.f;
      if (lane < 32) { unpack8(*(const u32x4*)(zr + 384 + lane * 8), f);
#pragma unroll
        for (int e = 0; e < 8; ++e) ss += f[e] * f[e]; }
      ss = wave_sum(ss);
      const float r = rsqrtf(ss * (1.f / 256.f) + EPS);
      if (lane < 32) {
#pragma unroll
        for (int e = 0; e < 8; ++e) o[e] = f[e] * r * P.kv_a_g[lane * 8 + e];
        *(u32x4*)(ckvn + (size_t)t * 256 + lane * 8) = pack8(o);
      }
    }
    if (lane < 8) *(u32x4*)(kr + (size_t)t * 64 + lane * 8) = *(const u32x4*)(zr + 640 + lane * 8);
    {
      const int c0 = lane * 8;
      float gb[8], a[8], cv[8];
      unpack8(*(const u32x4*)(zr + 704 + c0), gb);
      unpack8(*(const u32x4*)(zr + 1216 + c0), a);
#pragma unroll
      for (int e = 0; e < 8; ++e) cv[e] = P.conv_w[512 + c0 + e] * a[e];
      if (p > 0) {
        unpack8(*(const u32x4*)(zr - ZLD + 1216 + c0), a);
#pragma unroll
        for (int e = 0; e < 8; ++e) cv[e] += P.conv_w[c0 + e] * a[e];
      }
      if (p < L - 1) {
        unpack8(*(const u32x4*)(zr + ZLD + 1216 + c0), a);
#pragma unroll
        for (int e = 0; e < 8; ++e) cv[e] += P.conv_w[1024 + c0 + e] * a[e];
      }
#pragma unroll
      for (int e = 0; e < 8; ++e) o[e] = gb[e] * cv[e];
      *(u32x4*)(mix + (size_t)t * DM + 512 + c0) = pack8(o);
    }
  }
}

DI void zero_vt_pad(u16* vt, int rows, const int wv) {
  const u32x4 zz = {0u, 0u, 0u, 0u};
  for (int idx = obid() * NTHREADS + otid(wv); idx < rows * 6; idx += gridDim.x * NTHREADS) {
    const int row = idx / 6, c = idx - row * 6;
    *(u32x4*)(vt + (size_t)row * LP + L + c * 8) = zz;
  }
}

constexpr float LOG2_THETA = 13.287712379549449f;
constexpr float INV_2PI = 0.15915494309189535f;
DI void rope_sc(float pos, int j, float& sn, float& cs) {
  const float fr = exp2f(-(float)j * (LOG2_THETA / 32.f));
  float tr = pos * fr * INV_2PI;
  tr -= floorf(tr);
  sn = __builtin_amdgcn_sinf(tr);
  cs = __builtin_amdgcn_cosf(tr);
}

DI void e2_phase(const Params& P, const u16* __restrict__ qpre, const u16* __restrict__ knpre, const u16* __restrict__ kr,
                 u16* __restrict__ Qo, u16* __restrict__ Ko, const int wv) {
  const int tid_ = otid(wv), wave = tid_ >> 6, lane = tid_ & 63, hd = lane >> 4, i = lane & 15;
  for (int t = obid() * 8 + wave; t < T; t += gridDim.x * 8) {
    const int s = t / L, p = t - s * L;
    float sn[2], cs[2];
    rope_sc((float)p, 2 * i, sn[0], cs[0]); rope_sc((float)p, 2 * i + 1, sn[1], cs[1]);
#pragma unroll
    for (int which = 0; which < 2; ++which) {
      float nf[8], x1[2], x2[2];
      const float* gg = which ? P.k_g0 : P.q_g0;
      if (which == 0) {
        const u16* src = qpre + (size_t)t * 768 + hd * 192;
        unpack8(*(const u32x4*)(src + 8 * i), nf);
        const unsigned a = *(const unsigned*)(src + 128 + 2 * i), b = *(const unsigned*)(src + 160 + 2 * i);
        x1[0] = bf_lo(a); x1[1] = bf_hi(a); x2[0] = bf_lo(b); x2[1] = bf_hi(b);
      } else {
        unpack8(*(const u32x4*)(knpre + (size_t)t * 512 + hd * 128 + 8 * i), nf);
        const unsigned a = *(const unsigned*)(kr + (size_t)t * 64 + 2 * i), b = *(const unsigned*)(kr + (size_t)t * 64 + 32 + 2 * i);
        x1[0] = bf_lo(a); x1[1] = bf_hi(a); x2[0] = bf_lo(b); x2[1] = bf_hi(b);
      }
      float ss = x1[0] * x1[0] + x1[1] * x1[1] + x2[0] * x2[0] + x2[1] * x2[1];
#pragma unroll
      for (int e = 0; e < 8; ++e) ss += nf[e] * nf[e];
      ss = sum16(ss);
      const float r = rsqrtf(ss * (1.f / 192.f) + EPS);
#pragma unroll
      for (int e = 0; e < 8; ++e) nf[e] = nf[e] * r * gg[8 * i + e];
      float o1[2], o2[2];
#pragma unroll
      for (int e = 0; e < 2; ++e) {
        const float a = x1[e] * r * gg[128 + 2 * i + e], b = x2[e] * r * gg[160 + 2 * i + e];
        o1[e] = a * cs[e] - b * sn[e];
        o2[e] = b * cs[e] + a * sn[e];
      }
      if (which == 0) {
        constexpr float CQ = 0.07216878364870322f * 1.4426950408889634f;
#pragma unroll
        for (int e = 0; e < 8; ++e) nf[e] *= CQ;
        o1[0] *= CQ; o1[1] *= CQ; o2[0] *= CQ; o2[1] *= CQ;
      }
      u16* dst = (which ? Ko : Qo) + (size_t)t * 768 + hd * 192;
      *(u32x4*)(dst + 8 * i) = pack8(nf);
      *(unsigned*)(dst + 128 + 2 * i) = cvtpk(o1[0], o1[1]);
      *(unsigned*)(dst + 160 + 2 * i) = cvtpk(o2[0], o2[1]);
    }
  }
}

DI void e3_phase(const Params& P, const u16* __restrict__ qk, u16* __restrict__ Qo, u16* __restrict__ Ko, const int wv) {
  const int tid_ = otid(wv), wave = tid_ >> 6, lane = tid_ & 63, i = lane & 15;
  for (int t = obid() * 8 + wave; t < T; t += gridDim.x * 8) {
    const int s = t / L, p = t - s * L;
    float snr[2], csr[2], snc[2], csc[2];
    if (p >= NMETA) {
      const float row = (float)((p - NMETA) >> 6), col = (float)((p - NMETA) & 63);
      rope_sc(row, 2 * i, snr[0], csr[0]); rope_sc(row, 2 * i + 1, snr[1], csr[1]);
      rope_sc(col, 2 * i, snc[0], csc[0]); rope_sc(col, 2 * i + 1, snc[1], csc[1]);
    } else {
      snr[0] = snr[1] = snc[0] = snc[1] = 0.f; csr[0] = csr[1] = csc[0] = csc[1] = 1.f;
    }
#pragma unroll
    for (int hp = 0; hp < 3; ++hp) {
      const int head = hp * 4 + (lane >> 4);
      if (head < 10) {
        const u16* src = qk + (size_t)t * 1280 + head * 128;
        const float* gg = head < 8 ? P.q_g1 : P.k_g1;
        const unsigned ua1 = *(const unsigned*)(src + 2 * i), ua2 = *(const unsigned*)(src + 32 + 2 * i);
        const unsigned ub1 = *(const unsigned*)(src + 64 + 2 * i), ub2 = *(const unsigned*)(src + 96 + 2 * i);
        float a1[2] = {bf_lo(ua1), bf_hi(ua1)}, a2[2] = {bf_lo(ua2), bf_hi(ua2)};
        float b1[2] = {bf_lo(ub1), bf_hi(ub1)}, b2[2] = {bf_lo(ub2), bf_hi(ub2)};
        float ss = a1[0] * a1[0] + a1[1] * a1[1] + a2[0] * a2[0] + a2[1] * a2[1] + b1[0] * b1[0] + b1[1] * b1[1] + b2[0] * b2[0] + b2[1] * b2[1];
        ss = sum16(ss);
        const float r = rsqrtf(ss * (1.f / 128.f) + EPS);
        float oa1[2], oa2[2], ob1[2], ob2[2];
#pragma unroll
        for (int e = 0; e < 2; ++e) {
          const float xa1 = a1[e] * r * gg[2 * i + e], xa2 = a2[e] * r * gg[32 + 2 * i + e];
          const float xb1 = b1[e] * r * gg[64 + 2 * i + e], xb2 = b2[e] * r * gg[96 + 2 * i + e];
          oa1[e] = xa1 * csr[e] - xa2 * snr[e]; oa2[e] = xa2 * csr[e] + xa1 * snr[e];
          ob1[e] = xb1 * csc[e] - xb2 * snc[e]; ob2[e] = xb2 * csc[e] + xb1 * snc[e];
        }
        if (head < 8) {
          constexpr float CQ = 0.08838834764831845f * 1.4426950408889634f;
#pragma unroll
          for (int e = 0; e < 2; ++e) { oa1[e] *= CQ; oa2[e] *= CQ; ob1[e] *= CQ; ob2[e] *= CQ; }
        }
        u16* dst = head < 8 ? Qo + (size_t)t * 1024 + head * 128 : Ko + (size_t)t * 256 + (head - 8) * 128;
        *(unsigned*)(dst + 2 * i) = cvtpk(oa1[0], oa1[1]);
        *(unsigned*)(dst + 32 + 2 * i) = cvtpk(oa2[0], oa2[1]);
        *(unsigned*)(dst + 64 + 2 * i) = cvtpk(ob1[0], ob1[1]);
        *(unsigned*)(dst + 96 + 2 * i) = cvtpk(ob2[0], ob2[1]);
      }
    }
  }
}

#define RAW_BAR() do { asm volatile("s_waitcnt lgkmcnt(0)" ::: "memory"); __builtin_amdgcn_s_barrier(); asm volatile("" ::: "memory"); } while (0)
DI float xhalf_max(float x) {
  auto rr = __builtin_amdgcn_permlane32_swap(__float_as_uint(x), __float_as_uint(x), false, false);
  return fmaxf(__uint_as_float(rr[0]), __uint_as_float(rr[1]));
}
DI float xhalf_sum(float x) {
  auto rr = __builtin_amdgcn_permlane32_swap(__float_as_uint(x), __float_as_uint(x), false, false);
  return __uint_as_float(rr[0]) + __uint_as_float(rr[1]);
}
template <int DQK, int NHQ, int NHKV, bool HAS_META>
DI void attn_phase(const u16* __restrict__ Q, const u16* __restrict__ K, const u16* __restrict__ Vt, u16* __restrict__ O, const float* __restrict__ qg, const float* __restrict__ kg, char* smem, const int wv) {
  constexpr int NS = DQK / 16, CH = DQK / 8, KSTR = DQK * 2 + 16, VSTR = 144;
  constexpr int KBYTES = 64 * KSTR, VBYTES = 128 * VSTR;
  constexpr int NKC = 64 * CH / NTHREADS;
  constexpr int NT = (L + 63) / 64;
  constexpr bool EARLY_FETCH = (DQK == 128);
  constexpr int LDK = NHKV * DQK;
  static_assert(2 * (KBYTES + VBYTES) <= SMEM_BYTES, "attention LDS");
  const int tid = otid(wv), lane = tid & 63, wave = __builtin_amdgcn_readfirstlane(tid >> 6), r32 = lane & 31, hh = lane >> 5, grp = wave >> 2;
  constexpr int NF = NSEQ * NHQ * 16, nItems = NF + (HAS_META ? NSEQ * NHQ : 0);
#define A_DECODE(it_, hq_, sq_, q0_, ql_) do { if ((it_) < NF) { hq_ = ((it_) >> 4) % NHQ; sq_ = (it_) / (16 * NHQ); q0_ = NMETA + 256 * ((it_) & 15); ql_ = L; } \
    else { const int tt_ = (it_) - NF; hq_ = tt_ % NHQ; sq_ = tt_ / NHQ; q0_ = 0; ql_ = NMETA; } } while (0)
  char* kb0 = smem; char* vb0 = smem + 2 * KBYTES;
  const int lkey = tid >> 3, lc8 = tid & 7;
  const unsigned koff = (unsigned)(lkey * LDK * 2 + lc8 * 16);
  const unsigned koffL = (unsigned)(min(lkey, 15) * LDK * 2 + lc8 * 16);
  const unsigned voff = (unsigned)((lkey * LP + lc8 * 8) * 2);
  const unsigned kwoff = (unsigned)(lkey * KSTR + lc8 * 16), vwoff = (unsigned)(lkey * VSTR + lc8 * 16);
  const int G_ = (int)gridDim.x, b_ = obid();
  int item = (G_ % 8 == 0) ? (b_ % 8) * (G_ / 8) + b_ / 8 : b_;
  if (item >= nItems) return;
  u32x4 rk[NKC], rv[2];
#define A_LOADK(Kb_, tile_) do { const char* kp_ = (const char*)(Kb_) + (size_t)(tile_) * (64 * LDK * 2); const unsigned ko_ = ((tile_) == NT - 1) ? koffL : koff; \
    _Pragma("unroll") for (int i_ = 0; i_ < NKC; ++i_) rk[i_] = *(const u32x4*)(kp_ + ko_ + i_ * 128); } while (0)
#define A_LOADV(Vb_, tile_) do { const char* vp_ = (const char*)(Vb_) + (size_t)(tile_) * 128; \
    rv[0] = *(const u32x4*)(vp_ + voff); rv[1] = *(const u32x4*)(vp_ + voff + 64 * LP * 2); } while (0)
#define A_WRITEK(bi_) do { char* b_ = kb0 + (bi_) * KBYTES + kwoff; \
    _Pragma("unroll") for (int i_ = 0; i_ < NKC; ++i_) *(u32x4*)(b_ + i_ * 128) = rk[i_]; } while (0)
#define A_WRITEV(bi_) do { char* b_ = vb0 + (bi_) * VBYTES + vwoff; \
    *(u32x4*)(b_) = rv[0]; *(u32x4*)(b_ + 64 * VSTR) = rv[1]; } while (0)
#define A_FETCH(j_) do { \
        if ((j_) + 3 < NT) A_LOADK(Kb, (j_) + 3); \
        else if ((j_) == NT - 3 && has_next) A_LOADK(nKb, 0); \
        else if ((j_) == NT - 1 && has_next) A_LOADK(nKb, 1); \
        if ((j_) + 2 < NT) A_LOADV(Vb, (j_) + 2); \
        else if ((j_) == NT - 2 && has_next) A_LOADV(nVb, 0); } while (0)
#define A_QK(bi_) do { const char* sk_ = kb0 + (bi_) * KBYTES + r32 * KSTR + hh * 16; \
    _Pragma("unroll") for (int i_ = 0; i_ < 16; ++i_) { s0[i_] = 0.f; s1[i_] = 0.f; } \
    _Pragma("unroll") for (int i_ = 0; i_ < NS; ++i_) { \
      const bf16x8 k0f_ = *(const bf16x8*)(sk_ + i_ * 32); const bf16x8 k1f_ = *(const bf16x8*)(sk_ + 32 * KSTR + i_ * 32); \
      s0 = __builtin_amdgcn_mfma_f32_32x32x16_bf16(k0f_, qf[i_], s0, 0, 0, 0); \
      s1 = __builtin_amdgcn_mfma_f32_32x32x16_bf16(k1f_, qf[i_], s1, 0, 0, 0); } } while (0)
  int hq, sq, q0, qlim;
  A_DECODE(item, hq, sq, q0, qlim);
  const u16* Kb = K + (size_t)(sq * L) * LDK + (hq / (NHQ / NHKV)) * DQK;
  const u16* Vb = Vt + (size_t)((sq * NHKV + hq / (NHQ / NHKV)) * 128) * LP;
  A_LOADK(Kb, 0); A_WRITEK(0); A_LOADK(Kb, 1); A_LOADV(Vb, 0);
  if (grp == 1) { RAW_BAR(); }
  RAW_BAR();
  float l;
  f32x16 o[4], s0, s1;
  bf16x8 qf[NS], pb[4];
  for (;;) {
    const int pq = q0 + wave * 32 + r32;
    const bool valid = pq < qlim;
    const bool active = (item < NF) || (wave == 0);
    {
      const u16* qrow = Q + (size_t)(sq * L + (valid ? pq : qlim - 1)) * (NHQ * DQK) + hq * DQK + hh * 8;
#pragma unroll
      for (int i = 0; i < NS; ++i) qf[i] = *(const bf16x8*)(qrow + 16 * i);
    }
    l = 0.f;
#pragma unroll
    for (int d = 0; d < 4; ++d)
#pragma unroll
      for (int i = 0; i < 16; ++i) o[d][i] = 0.f;
    const int nitem = item + (int)gridDim.x;
    const bool has_next = nitem < nItems;
    int nhq, nsq, nq0, nqlim;
    A_DECODE(nitem, nhq, nsq, nq0, nqlim);
    const u16* nKb = K + (size_t)(nsq * L) * LDK + (nhq / (NHQ / NHKV)) * DQK;
    const u16* nVb = Vt + (size_t)((nsq * NHKV + nhq / (NHQ / NHKV)) * 128) * LP;
    RAW_BAR();
    A_WRITEK(1); A_WRITEV(0);
    __builtin_amdgcn_sched_barrier(0);
    if (active) A_QK(0);
    __builtin_amdgcn_sched_barrier(0);
    A_LOADK(Kb, 2); A_LOADV(Vb, 1);
    RAW_BAR();
    for (int j = 0; j < NT; ++j) {
      __builtin_amdgcn_s_setprio(0);
      if (active) {
        f32x2 ps2 = {0.f, 0.f};
        unsigned w_[16];
#pragma unroll
        for (int i = 0; i < 8; ++i) {
          f32x2 v;
          v[0] = __builtin_amdgcn_exp2f(s0[2 * i]); v[1] = __builtin_amdgcn_exp2f(s0[2 * i + 1]);
          if (j == NT - 1 && i >= 4) v = f32x2{0.f, 0.f};
          ps2 += v;
          w_[i] = cvtpk(v[0], v[1]);
        }
#pragma unroll
        for (int i = 0; i < 8; ++i) {
          f32x2 v;
          v[0] = __builtin_amdgcn_exp2f(s1[2 * i]); v[1] = __builtin_amdgcn_exp2f(s1[2 * i + 1]);
          if (j == NT - 1) v = f32x2{0.f, 0.f};
          ps2 += v;
          w_[8 + i] = cvtpk(v[0], v[1]);
        }
        l += xhalf_sum(ps2[0] + ps2[1]);
        pb[0] = __builtin_bit_cast(bf16x8, u32x4{w_[0], w_[1], w_[2], w_[3]});
        pb[1] = __builtin_bit_cast(bf16x8, u32x4{w_[4], w_[5], w_[6], w_[7]});
        pb[2] = __builtin_bit_cast(bf16x8, u32x4{w_[8], w_[9], w_[10], w_[11]});
        pb[3] = __builtin_bit_cast(bf16x8, u32x4{w_[12], w_[13], w_[14], w_[15]});
      }
      __builtin_amdgcn_s_setprio(2);
      RAW_BAR();
      if (j + 2 < NT) A_WRITEK(j & 1);
      else if (j == NT - 1 && has_next) A_WRITEK(0);
      if (j + 1 < NT) A_WRITEV((j + 1) & 1);
      __builtin_amdgcn_sched_barrier(0);
      if constexpr (EARLY_FETCH) { A_FETCH(j); __builtin_amdgcn_sched_barrier(0); }
        if (active && j == NT - 1) {
        const char* svl = vb0 + (j & 1) * VBYTES + r32 * VSTR + hh * 16;
        bf16x8 vf[4];
#pragma unroll
        for (int d = 0; d < 4; ++d) vf[d] = *(const bf16x8*)(svl + d * 32 * VSTR);
#pragma unroll
        for (int d = 0; d < 4; ++d) o[d] = __builtin_amdgcn_mfma_f32_32x32x16_bf16(vf[d], pb[0], o[d], 0, 0, 0);
      } else if (active)
      {
        constexpr int NQK = 2 * NS, NM = NQK + 16, RING = (DQK == 128) ? 8 : 6;
        const char* sk = kb0 + ((j + 1) & 1) * KBYTES + r32 * KSTR + hh * 16;
        const char* sv = vb0 + (j & 1) * VBYTES + r32 * VSTR + hh * 16;
        bf16x8 ring[RING];
#define A_FRAG(dst_, i_) do { if ((i_) < NQK) { dst_ = *(const bf16x8*)(sk + ((i_) & 1) * (32 * KSTR) + ((i_) >> 1) * 32); } \
          else { dst_ = *(const bf16x8*)(sv + (((i_) - NQK) & 3) * (32 * VSTR) + (((i_) - NQK) >> 2) * 32); } } while (0)
#pragma unroll
        for (int i = 0; i < 16; ++i) { s0[i] = 0.f; s1[i] = 0.f; }
#pragma unroll
        for (int i = 0; i < RING; ++i) A_FRAG(ring[i], i);
#pragma unroll
        for (int i = 0; i < NM; ++i) {
          if (i < NQK) {
            if (i & 1) s1 = __builtin_amdgcn_mfma_f32_32x32x16_bf16(ring[i % RING], qf[i >> 1], s1, 0, 0, 0);
            else       s0 = __builtin_amdgcn_mfma_f32_32x32x16_bf16(ring[i % RING], qf[i >> 1], s0, 0, 0, 0);
          } else {
            o[(i - NQK) & 3] = __builtin_amdgcn_mfma_f32_32x32x16_bf16(ring[i % RING], pb[(i - NQK) >> 2], o[(i - NQK) & 3], 0, 0, 0);
          }
          if (i + RING < NM) A_FRAG(ring[i % RING], i + RING);
          __builtin_amdgcn_sched_barrier(0);
        }
#undef A_FRAG
      }
        __builtin_amdgcn_sched_barrier(0);
      if constexpr (!EARLY_FETCH) A_FETCH(j);
      if (j == NT - 1 && valid) {
        const float inv = 1.f / l;
        u16* orow = O + (size_t)(HAS_META ? sq * L + pq : sq * SEQ + pq - NMETA) * DM + hq * 128 + hh * 4;
#pragma unroll
        for (int d = 0; d < 4; ++d)
#pragma unroll
          for (int q = 0; q < 4; ++q) {
            u32x2 w = {cvtpk(o[d][4 * q] * inv, o[d][4 * q + 1] * inv), cvtpk(o[d][4 * q + 2] * inv, o[d][4 * q + 3] * inv)};
            *(u32x2*)(orow + d * 32 + q * 8) = w;
          }
      }
      RAW_BAR();
    }
    if (!has_next) break;
    item = nitem; hq = nhq; sq = nsq; q0 = nq0; qlim = nqlim; Kb = nKb; Vb = nVb;
  }
  __builtin_amdgcn_s_setprio(0);
  if (grp == 0) RAW_BAR();
  RAW_BAR();
#undef A_LOADK
#undef A_LOADV
#undef A_WRITEK
#undef A_WRITEV
#undef A_QK
#undef A_FETCH
#undef A_DECODE
}

template <int NHQ, int NHKV>
DI void attn_phase_l1(const u16* __restrict__ Q, const u16* __restrict__ K, const u16* __restrict__ Vt, u16* __restrict__ O, char* smem, const int wv) {
  constexpr int DQK = 128, NS = 8, KSTR = DQK * 2 + 16, VSTR = 144;
  constexpr int KBYTES = 64 * KSTR, VBYTES = 128 * VSTR;
  constexpr int NKC = 2;
  constexpr int NT = (L + 63) / 64;
  constexpr int LDK = NHKV * DQK;
  constexpr int NF = NSEQ * NHQ * 16;
  const int tid = otid(wv), lane = tid & 63, wave = __builtin_amdgcn_readfirstlane(tid >> 6), r32 = lane & 31, hh = lane >> 5;
  char* kb0 = smem; char* vb0 = smem + 2 * KBYTES;
  const int lkey = tid >> 3, lc8 = tid & 7;
  const unsigned koff = (unsigned)(lkey * LDK * 2 + lc8 * 16);
  const unsigned koffL = (unsigned)(min(lkey, 15) * LDK * 2 + lc8 * 16);
  const unsigned voff = (unsigned)((lkey * LP + lc8 * 8) * 2);
  const unsigned kwoff = (unsigned)(lkey * KSTR + lc8 * 16), vwoff = (unsigned)(lkey * VSTR + lc8 * 16);
  const int G_ = (int)gridDim.x, b_ = obid();
  u32x4 rk[NKC], rv[2];
#define B_LOADK(Kb_, tile_) do { const char* kp_ = (const char*)(Kb_) + (size_t)(tile_) * (64 * LDK * 2); const unsigned ko_ = ((tile_) == NT - 1) ? koffL : koff; \
    _Pragma("unroll") for (int i_ = 0; i_ < NKC; ++i_) rk[i_] = *(const u32x4*)(kp_ + ko_ + i_ * 128); } while (0)
#define B_LOADV(Vb_, tile_) do { const char* vp_ = (const char*)(Vb_) + (size_t)(tile_) * 128; \
    rv[0] = *(const u32x4*)(vp_ + voff); rv[1] = *(const u32x4*)(vp_ + voff + 64 * LP * 2); } while (0)
#define B_WRITEK(bi_) do { char* b_w = kb0 + (bi_) * KBYTES + kwoff; \
    _Pragma("unroll") for (int i_ = 0; i_ < NKC; ++i_) *(u32x4*)(b_w + i_ * 128) = rk[i_]; } while (0)
#define B_WRITEV(bi_) do { char* b_w = vb0 + (bi_) * VBYTES + vwoff; \
    *(u32x4*)(b_w) = rv[0]; *(u32x4*)(b_w + 64 * VSTR) = rv[1]; } while (0)
  f32x16 o[4], s0, s1;
  bf16x8 qf[NS], pb[4];
  for (int item = (G_ % 8 == 0) ? (b_ % 8) * (G_ / 8) + b_ / 8 : b_; item < NF; item += G_) {
    const int hq = (item >> 4) % NHQ, sq = item / (16 * NHQ), q0 = NMETA + 256 * (item & 15);
    const u16* Kb = K + (size_t)(sq * L) * LDK + (hq / (NHQ / NHKV)) * DQK;
    const u16* Vb = Vt + (size_t)((sq * NHKV + hq / (NHQ / NHKV)) * 128) * LP;
    const int pq = q0 + wave * 32 + r32;
    {
      const u16* qrow = Q + (size_t)(sq * L + pq) * (NHQ * DQK) + hq * DQK + hh * 8;
#pragma unroll
      for (int i = 0; i < NS; ++i) qf[i] = *(const bf16x8*)(qrow + 16 * i);
    }
    float l = 0.f;
#pragma unroll
    for (int d = 0; d < 4; ++d)
#pragma unroll
      for (int i = 0; i < 16; ++i) o[d][i] = 0.f;
    __syncthreads();
    B_LOADK(Kb, 0); B_WRITEK(0); B_LOADK(Kb, 1); B_WRITEK(1); B_LOADV(Vb, 0); B_WRITEV(0);
    B_LOADK(Kb, 2); B_LOADV(Vb, 1);
    __syncthreads();
    {
      const char* sk = kb0 + r32 * KSTR + hh * 16;
#pragma unroll
      for (int i = 0; i < 16; ++i) { s0[i] = 0.f; s1[i] = 0.f; }
#pragma unroll
      for (int i = 0; i < NS; ++i) {
        const bf16x8 k0f = *(const bf16x8*)(sk + i * 32), k1f = *(const bf16x8*)(sk + 32 * KSTR + i * 32);
        s0 = __builtin_amdgcn_mfma_f32_32x32x16_bf16(k0f, qf[i], s0, 0, 0, 0);
        s1 = __builtin_amdgcn_mfma_f32_32x32x16_bf16(k1f, qf[i], s1, 0, 0, 0);
      }
      unsigned w_[16]; f32x2 ps2 = {0.f, 0.f};
#pragma unroll
      for (int i = 0; i < 8; ++i) { f32x2 v; v[0] = __builtin_amdgcn_exp2f(s0[2 * i]); v[1] = __builtin_amdgcn_exp2f(s0[2 * i + 1]); ps2 += v; w_[i] = cvtpk(v[0], v[1]); }
#pragma unroll
      for (int i = 0; i < 8; ++i) { f32x2 v; v[0] = __builtin_amdgcn_exp2f(s1[2 * i]); v[1] = __builtin_amdgcn_exp2f(s1[2 * i + 1]); ps2 += v; w_[8 + i] = cvtpk(v[0], v[1]); }
      l += ps2[0] + ps2[1];
#pragma unroll
      for (int q = 0; q < 4; ++q) pb[q] = __builtin_bit_cast(bf16x8, u32x4{w_[4 * q], w_[4 * q + 1], w_[4 * q + 2], w_[4 * q + 3]});
    }
    asm volatile("s_waitcnt lgkmcnt(0)" ::: "memory"); __builtin_amdgcn_s_barrier(); asm volatile("" ::: "memory");
    for (int j = 0; j < NT; ++j) {
      if (j + 2 < NT) B_WRITEK(j & 1);
      if (j + 1 < NT) B_WRITEV((j + 1) & 1);
      __builtin_amdgcn_sched_barrier(0);
      if (j + 3 < NT) B_LOADK(Kb, j + 3);
      if (j + 2 < NT) B_LOADV(Vb, j + 2);
      __builtin_amdgcn_sched_barrier(0);
      if (j == NT - 1) {
        const char* svl = vb0 + (j & 1) * VBYTES + r32 * VSTR + hh * 16;
        bf16x8 vf[4];
#pragma unroll
        for (int d = 0; d < 4; ++d) vf[d] = *(const bf16x8*)(svl + d * 32 * VSTR);
#pragma unroll
        for (int d = 0; d < 4; ++d) o[d] = __builtin_amdgcn_mfma_f32_32x32x16_bf16(vf[d], pb[0], o[d], 0, 0, 0);
      } else {
        constexpr int NQK = 2 * NS, NM = NQK + 16, RING = 8;
        const char* sk = kb0 + ((j + 1) & 1) * KBYTES + r32 * KSTR + hh * 16;
        const char* sv = vb0 + (j & 1) * VBYTES + r32 * VSTR + hh * 16;
        bf16x8 ring[RING];
        unsigned w_[16]; f32x2 ps2 = {0.f, 0.f};
#define B_FRAG(dst_, i_) do { if ((i_) < NQK) { dst_ = *(const bf16x8*)(sk + ((i_) & 1) * (32 * KSTR) + ((i_) >> 1) * 32); } \
          else { dst_ = *(const bf16x8*)(sv + (((i_) - NQK) & 3) * (32 * VSTR) + (((i_) - NQK) >> 2) * 32); } } while (0)
#pragma unroll
        for (int i = 0; i < 16; ++i) { s0[i] = 0.f; s1[i] = 0.f; }
#pragma unroll
        for (int i = 0; i < RING; ++i) B_FRAG(ring[i], i);
#pragma unroll
        for (int i = 0; i < NM; ++i) {
          if (i < NQK) {
            if (i & 1) s1 = __builtin_amdgcn_mfma_f32_32x32x16_bf16(ring[i % RING], qf[i >> 1], s1, 0, 0, 0);
            else       s0 = __builtin_amdgcn_mfma_f32_32x32x16_bf16(ring[i % RING], qf[i >> 1], s0, 0, 0, 0);
          } else {
            o[(i - NQK) & 3] = __builtin_amdgcn_mfma_f32_32x32x16_bf16(ring[i % RING], pb[(i - NQK) >> 2], o[(i - NQK) & 3], 0, 0, 0);
          }
          if (i + RING < NM) B_FRAG(ring[i % RING], i + RING);
          if (i >= NQK + 2) {
            const int g = i - NQK - 2;
            f32x2 v;
            if (g < 8) { v[0] = __builtin_amdgcn_exp2f(s0[2 * g]); v[1] = __builtin_amdgcn_exp2f(s0[2 * g + 1]); }
            else       { v[0] = __builtin_amdgcn_exp2f(s1[2 * (g - 8)]); v[1] = __builtin_amdgcn_exp2f(s1[2 * (g - 8) + 1]); }
            ps2 += v; w_[g] = cvtpk(v[0], v[1]);
          }
          __builtin_amdgcn_sched_barrier(0);
        }
#pragma unroll
        for (int g = 14; g < 16; ++g) { f32x2 v; v[0] = __builtin_amdgcn_exp2f(s1[2 * (g - 8)]); v[1] = __builtin_amdgcn_exp2f(s1[2 * (g - 8) + 1]); ps2 += v; w_[g] = cvtpk(v[0], v[1]); }
#undef B_FRAG
        if (j + 1 == NT - 1) {
          ps2 = f32x2{0.f, 0.f};
#pragma unroll
          for (int g = 0; g < 4; ++g) { ps2[0] += __builtin_amdgcn_exp2f(s0[2 * g]); ps2[1] += __builtin_amdgcn_exp2f(s0[2 * g + 1]); }
#pragma unroll
          for (int g = 4; g < 16; ++g) w_[g] = 0u;
        }
        if (j + 1 < NT) {
          l += ps2[0] + ps2[1];
#pragma unroll
          for (int q = 0; q < 4; ++q) pb[q] = __builtin_bit_cast(bf16x8, u32x4{w_[4 * q], w_[4 * q + 1], w_[4 * q + 2], w_[4 * q + 3]});
        }
      }
      asm volatile("s_waitcnt lgkmcnt(0)" ::: "memory"); __builtin_amdgcn_s_barrier(); asm volatile("" ::: "memory");
    }
    {
      const float inv = 1.f / xhalf_sum(l);
      u16* orow = O + (size_t)(sq * SEQ + pq - NMETA) * DM + hq * 128 + hh * 4;
#pragma unroll
      for (int d = 0; d < 4; ++d)
#pragma unroll
        for (int q = 0; q < 4; ++q) {
          u32x2 w = {cvtpk(o[d][4 * q] * inv, o[d][4 * q + 1] * inv), cvtpk(o[d][4 * q + 2] * inv, o[d][4 * q + 3] * inv)};
          *(u32x2*)(orow + d * 32 + q * 8) = w;
        }
    }
  }
  __syncthreads();
#undef B_LOADK
#undef B_LOADV
#undef B_WRITEK
#undef B_WRITEV
}

#define XB_TMO      128
#define XB_XCNT(j)  (256  + 64 * (j))
#define XB_XSUB(j)  (1280 + 64 * (j))
#define XB_XGEN(j)  (2304 + 64 * (j))
#define XB_TOP      3328
#define XB_TOPGEN   3392
#define XCD_BAR_WORDS 3456
#define XB_SPIN_CAP (1u << 18)
#define LAS3 __attribute__((address_space(3)))
DI unsigned xb_ld(unsigned* p) { return __hip_atomic_load(p, __ATOMIC_RELAXED, __HIP_MEMORY_SCOPE_AGENT); }
DI unsigned xb_add(unsigned* p, unsigned v) { return __hip_atomic_fetch_add(p, v, __ATOMIC_RELAXED, __HIP_MEMORY_SCOPE_AGENT); }
DI unsigned xb_xcc_id() { return (unsigned)__builtin_amdgcn_s_getreg((3 << 11) | 20) & 0xFu; }
#define XB_SPIN(cond, bar) do { unsigned _sp = 0; while (cond) { __builtin_amdgcn_s_sleep(1); \
    if ((++_sp & 255u) == 0u) { if (xb_ld(&(bar)[XB_TMO])) break; if (_sp > XB_SPIN_CAP) { atomicAdd(&(bar)[XB_TMO], 1u); break; } } } } while (0)
struct XcdBarrier { unsigned* bar; unsigned x; volatile LAS3 unsigned* st; };
DI XcdBarrier xcd_barrier_post(unsigned* bar, volatile LAS3 unsigned* st) {
  XcdBarrier b; b.bar = bar; b.x = xb_xcc_id(); b.st = st;
  if (threadIdx.x == 0) (void)xb_add(&bar[XB_XCNT(b.x)], 1u);
  return b;
}
DI void xcd_barrier_complete(unsigned* bar, unsigned x, unsigned& nloc, unsigned& nx) {
  const unsigned G = gridDim.x * gridDim.y * gridDim.z;
  unsigned sum, cnt, mine, sp = 0u;
  for (;;) {
    sum = 0u; cnt = 0u; mine = 0u;
#pragma unroll
    for (unsigned j = 0; j < 16; ++j) { const unsigned c = xb_ld(&bar[XB_XCNT(j)]); sum += c; cnt += (c > 0u) ? 1u : 0u; mine = (j == x) ? c : mine; }
    if (sum == G) break;
    __builtin_amdgcn_s_sleep(1);
    if ((++sp & 255u) == 0u) { if (xb_ld(&bar[XB_TMO])) break; if (sp > XB_SPIN_CAP) { atomicAdd(&bar[XB_TMO], 1u); break; } }
  }
  nloc = mine > 0u ? mine : 1u; nx = cnt > 0u ? cnt : 1u;
}
DI void xcd_barrier(unsigned* bar, const unsigned x, volatile LAS3 unsigned* st) {
  asm volatile("s_waitcnt vmcnt(0)" ::: "memory");
  __syncthreads();
  if (threadIdx.x == 0) {
    __builtin_amdgcn_s_waitcnt(0);
    unsigned nloc = st[0], nx = st[1];
    if (nloc == 0u) { xcd_barrier_complete(bar, x, nloc, nx); st[0] = nloc; st[1] = nx; }
    const unsigned old = xb_add(&bar[XB_XSUB(x)], 1u);
    const unsigned gen = old / nloc;
    if (old + 1u == (gen + 1u) * nloc) {
      __builtin_amdgcn_fence(__ATOMIC_RELEASE, "agent");
      asm volatile("s_waitcnt vmcnt(0)" ::: "memory");
      const unsigned og = xb_add(&bar[XB_TOP], 1u);
      const unsigned tg = og / nx;
      if (og + 1u == (tg + 1u) * nx) xb_add(&bar[XB_TOPGEN], 1u);
      else XB_SPIN(xb_ld(&bar[XB_TOPGEN]) == tg, bar);
      __builtin_amdgcn_fence(__ATOMIC_ACQUIRE, "agent");
      xb_add(&bar[XB_XGEN(x)], 1u);
      asm volatile("s_waitcnt vmcnt(0)" ::: "memory");
    } else {
      XB_SPIN(xb_ld(&bar[XB_XGEN(x)]) == gen, bar);
      __builtin_amdgcn_fence(__ATOMIC_ACQUIRE, "agent");
      asm volatile("s_waitcnt vmcnt(0)" ::: "memory");
    }
  }
  __syncthreads();
}
constexpr size_t O_BAR = 47 * MiB + 512 * 1024;

template <class Tp> DI Tp* uni(Tp* p) {
  const unsigned long long v = (unsigned long long)p;
  const unsigned lo = __builtin_amdgcn_readfirstlane((unsigned)v), hi = __builtin_amdgcn_readfirstlane((unsigned)(v >> 32));
  typedef __attribute__((address_space(1))) Tp* gptr_t;
  return (Tp*)(gptr_t)(((unsigned long long)hi << 32) | lo);
}
DI Params ld_params() {
  const volatile __attribute__((address_space(4))) Params* kp = (const volatile __attribute__((address_space(4))) Params*)__builtin_amdgcn_kernarg_segment_ptr();
  Params r;
#define LDF(f_) r.f_ = uni(kp->f_)
  LDF(xp); LDF(xs); LDF(meta); LDF(mix_g); LDF(ffn_g); LDF(w_in); LDF(q_a_g); LDF(kv_a_g); LDF(w_uq); LDF(w_ukv); LDF(q_g0); LDF(k_g0);
  LDF(conv_w); LDF(w_out0); LDF(w_qkv); LDF(q_g1); LDF(k_g1); LDF(w_out1); LDF(w1); LDF(w3); LDF(w2); LDF(out); LDF(ws); LDF(hmeta);
#undef LDF
  return r;
}
constexpr size_t O_W = OFF_W, O_SS = 46 * MiB, O_R1 = OFF_R1, O_R2 = OFF_R2, O_R3 = OFF_R3, O_HBA = 800 * MiB;
constexpr size_t O_Z = O_R2, O_QPRE = O_R2, O_KNPRE = O_R2 + 145 * MiB, O_CQN = O_R3, O_CKVN = O_R3 + 73 * MiB, O_VT0 = O_R3 + 122 * MiB,
                 O_KR = O_R3 + 220 * MiB, O_ACT = O_R2, O_QKPRE = O_R2, O_VT1 = O_R3, O_Q1 = O_R3 + 49 * MiB, O_K1 = O_R3 + 242 * MiB;
constexpr size_t O_K0_IN_OUT = 145 * MiB;
#define WSP(P_, off_) ((u16*)((P_).ws + (off_)))
#define WW(P_, woff_) (WSP(P_, O_W) + (woff_))

__global__ void __launch_bounds__(NTHREADS) fwd_megakernel(Params Punused) {
  extern __shared__ __attribute__((aligned(16))) char smem[];
  cg::grid_group grid = cg::this_grid();
  const int wv = __builtin_amdgcn_readfirstlane((int)(threadIdx.x >> 6));
  volatile LAS3 unsigned* xst = (volatile LAS3 unsigned*)(smem + pg8::STAGE_BYTES);
  if (threadIdx.x < 4) xst[threadIdx.x] = 0u;
  __syncthreads();
  { const Params P = ld_params(); (void)xcd_barrier_post((unsigned*)(P.ws + O_BAR), xst); }
#define GRID_BAR() do { const Params Pb_ = ld_params(); xcd_barrier((unsigned*)(Pb_.ws + O_BAR), xb_xcc_id(), xst); } while (0)
  {
    const Params P = ld_params();
    u16* W = WSP(P, O_W);
    transpose_job(P.w_in, W + W_IN, 1024, IN0, 4, nullptr, wv);
    transpose_job(P.w_uq, W + W_UQ, 384, 768, 0, nullptr, wv);
    transpose_job(P.w_ukv, W + W_UKV, 256, 1024, 0, nullptr, wv);
    transpose_job(P.w_out0, W + W_OUT0, 1024, 1024, 0, nullptr, wv);
    transpose_job(P.w_qkv, W + W_QKV, 1024, 1536, 0, P.mix_g + DM, wv);
    transpose_job(P.w_out1, W + W_OUT1, 1024, 1024, 0, nullptr, wv);
    for (int l = 0; l < 2; ++l) {
      transpose_job(P.w1 + (size_t)l * 1024 * FFN, W + W_13 + (size_t)l * 5632 * 1024, 1024, FFN, 1, P.ffn_g + l * DM, wv);
      transpose_job(P.w3 + (size_t)l * 1024 * FFN, W + W_13 + (size_t)l * 5632 * 1024, 1024, FFN, 2, P.ffn_g + l * DM, wv);
      transpose_job(P.w2 + (size_t)l * 1024 * FFN, W + W_2 + (size_t)l * 1024 * FFN, FFN, 1024, 0, nullptr, wv);
    }
    norm_phase<true>(P, P.mix_g, WSP(P, O_R1), wv);
    float* ssq = (float*)(P.ws + O_SS);
    for (int i = obid() * NTHREADS + otid(wv); i < 3 * T; i += gridDim.x * NTHREADS) ssq[i] = 0.f;
  }
  grid.sync();
  { const Params P = ld_params();
    run_gemm(smem, WSP(P, O_R1), WW(P, W_IN), 2304, 1024, EpiZ{WSP(P, O_Z)}, 0, wv); }
  GRID_BAR();
  { const Params P = ld_params();
    e1_phase(P, WSP(P, O_Z), WSP(P, O_CQN), WSP(P, O_CKVN), WSP(P, O_KR), WSP(P, O_R1), wv); }
  GRID_BAR();
  { const Params P = ld_params();
    run_gemm(smem, WSP(P, O_CQN), WW(P, W_UQ), 768, 384, EpiStore{WSP(P, O_QPRE), 768, 768}, 0, wv); }
  { const Params P = ld_params();
    run_gemm(smem, WSP(P, O_CKVN), WW(P, W_UKV), 1024, 256, EpiKV0{WSP(P, O_KNPRE), WSP(P, O_VT0)}, (int)gridDim.x - (3 * (TP / 256)) % (int)gridDim.x, wv); }
  GRID_BAR();
  { const Params P = ld_params();
    e2_phase(P, WSP(P, O_QPRE), WSP(P, O_KNPRE), WSP(P, O_KR), (u16*)P.out, (u16*)((char*)P.out + O_K0_IN_OUT), wv);
    zero_vt_pad(WSP(P, O_VT0), NSEQ * 4 * 128, wv); }
  GRID_BAR();
  { const Params P = ld_params();
    attn_phase<192, 4, 4, true>((const u16*)P.out, (const u16*)((char*)P.out + O_K0_IN_OUT), WSP(P, O_VT0), WSP(P, O_R1), P.q_g0, P.k_g0, smem, wv); }
  GRID_BAR();
  { const Params P = ld_params();
    run_gemm(smem, WSP(P, O_R1), WW(P, W_OUT0), 1024, 1024, EpiRes<0>{P, nullptr, WSP(P, O_HBA), (float*)(P.ws + O_SS)}, 0, wv); }
  GRID_BAR();
  { const Params P = ld_params();
    run_gemm(smem, WSP(P, O_HBA), WW(P, W_13), 5632, 1024, EpiSwiglu{WSP(P, O_ACT), (const float*)(P.ws + O_SS)}, 0, wv); }
  GRID_BAR();
  { const Params P = ld_params();
    run_gemm(smem, WSP(P, O_ACT), WW(P, W_2), 1024, FFN, EpiRes<1>{P, WSP(P, O_HBA), WSP(P, O_R1), (float*)(P.ws + O_SS) + T}, 0, wv); }
  GRID_BAR();
  { const Params P = ld_params();
    run_gemm(smem, WSP(P, O_R1), WW(P, W_QKV), 1536, 1024, EpiQKV1{WSP(P, O_QKPRE), WSP(P, O_VT1), (const float*)(P.ws + O_SS) + T}, 0, wv); }
  GRID_BAR();
  { const Params P = ld_params();
    e3_phase(P, WSP(P, O_QKPRE), WSP(P, O_Q1), WSP(P, O_K1), wv);
    zero_vt_pad(WSP(P, O_VT1), NSEQ * 2 * 128, wv); }
  GRID_BAR();
  { const Params P = ld_params();
    attn_phase_l1<8, 2>(WSP(P, O_Q1), WSP(P, O_K1), WSP(P, O_VT1), (u16*)P.out, smem, wv); }
  GRID_BAR();
  { const Params P = ld_params();
    run_gemm(smem, (const u16*)P.out, WW(P, W_OUT1), 1024, 1024, EpiRes<3>{P, WSP(P, O_R1), WSP(P, O_HBA), (float*)(P.ws + O_SS) + 2 * T}, 0, wv, TQ); }
  GRID_BAR();
  { const Params P = ld_params();
    run_gemm(smem, WSP(P, O_HBA), WW(P, W_13 + (size_t)5632 * 1024), 5632, 1024, EpiSwiglu{WSP(P, O_ACT), (const float*)(P.ws + O_SS) + 2 * T}, 0, wv, TQ); }
  GRID_BAR();
  { const Params P = ld_params();
    run_gemm(smem, WSP(P, O_ACT), WW(P, W_2 + (size_t)1024 * FFN), 1024, FFN, EpiRes<4>{P, WSP(P, O_HBA), nullptr, nullptr}, 0, wv, TQ); }
}

extern "C" void kernel_launch(void* const* d_in, const int* in_sizes, int n_in, void* d_out, int out_size, void* d_ws, size_t ws_size,
                              hipStream_t stream) {
  static int grid_blocks = 0;
  if (!grid_blocks) {
    if (hipFuncSetAttribute((const void*)fwd_megakernel, hipFuncAttributeMaxDynamicSharedMemorySize, SMEM_BYTES) != hipSuccess)
      fprintf(stderr, "kernel_launch: hipFuncSetAttribute failed\n");
    int dev = 0, cus = 0, per_cu = 0;
    hipGetDevice(&dev);
    hipDeviceGetAttribute(&cus, hipDeviceAttributeMultiprocessorCount, dev);
    if (hipOccupancyMaxActiveBlocksPerMultiprocessor(&per_cu, (const void*)fwd_megakernel, NTHREADS, SMEM_BYTES) != hipSuccess || per_cu < 1) per_cu = 1;
    (void)hipGetLastError();
    grid_blocks = cus * per_cu;
  }
  Params p;
  memset(&p, 0, sizeof(p));
  p.xp = (const float*)d_in[0]; p.xs = (const float*)d_in[1]; p.meta = (const float*)d_in[2]; p.mix_g = (const float*)d_in[3];
  p.ffn_g = (const float*)d_in[4]; p.w_in = (const float*)d_in[5]; p.q_a_g = (const float*)d_in[6]; p.kv_a_g = (const float*)d_in[7];
  p.w_uq = (const float*)d_in[8]; p.w_ukv = (const float*)d_in[9]; p.q_g0 = (const float*)d_in[10]; p.k_g0 = (const float*)d_in[11];
  p.conv_w = (const float*)d_in[12]; p.w_out0 = (const float*)d_in[13]; p.w_qkv = (const float*)d_in[14]; p.q_g1 = (const float*)d_in[15];
  p.k_g1 = (const float*)d_in[16]; p.w_out1 = (const float*)d_in[17]; p.w1 = (const float*)d_in[18]; p.w3 = (const float*)d_in[19];
  p.w2 = (const float*)d_in[20];
  p.out = (float*)d_out; p.ws = (char*)d_ws; p.hmeta = (float*)((char*)d_ws + OFF_HM);
  (void)hipMemsetAsync((char*)d_ws + O_BAR, 0, XCD_BAR_WORDS * sizeof(unsigned), stream);
  void* args[] = {&p};
  hipError_t e = hipLaunchCooperativeKernel((const void*)fwd_megakernel, dim3(grid_blocks), dim3(NTHREADS), args, SMEM_BYTES, stream);
  if (e != hipSuccess) fprintf(stderr, "cooperative launch failed: %s (grid %d)\n", hipGetErrorString(e), grid_blocks);
}
```

```cpp
#include <hip/hip_runtime.h>
#include <hip/hip_cooperative_groups.h>
#include <cstdio>
#include <cstring>
namespace cg = cooperative_groups;

#define DI __device__ __forceinline__
typedef unsigned short u16;
using bf16x8   = __attribute__((ext_vector_type(8))) short;
using f32x16   = __attribute__((ext_vector_type(16))) float;
using f32x4    = __attribute__((ext_vector_type(4))) float;
using f32x2    = __attribute__((ext_vector_type(2))) float;
using u32x4    = __attribute__((ext_vector_type(4))) unsigned;
using u32x2    = __attribute__((ext_vector_type(2))) unsigned;
using bf16x2_t = __attribute__((ext_vector_type(2))) __bf16;

constexpr int NTHREADS = 512;
constexpr int DM = 1024, NSEQ = 24, NMETA = 16, SEQ = 4096, L = SEQ + NMETA, LP = 4160, T = NSEQ * L;
constexpr int IN0 = 2240, FFN = 2816;
constexpr float EPS = 1e-6f;

constexpr size_t MiB = 1024 * 1024;
constexpr size_t OFF_W = 0, OFF_HM = 48 * MiB, OFF_R1 = 50 * MiB, OFF_R2 = 243 * MiB, OFF_R3 = 665 * MiB;
constexpr size_t W_IN = 0, W_UQ = W_IN + (size_t)2304 * 1024, W_UKV = W_UQ + 768 * 384, W_OUT0 = W_UKV + 1024 * 256,
                 W_QKV = W_OUT0 + 1024 * 1024, W_OUT1 = W_QKV + 1536 * 1024, W_13 = W_OUT1 + 1024 * 1024,
                 W_2 = W_13 + 2 * (size_t)5632 * 1024, W_END = W_2 + 2 * (size_t)1024 * FFN;
static_assert(W_END * 2 <= 48 * MiB, "weights region");

struct Params {
  const float *xp, *xs, *meta, *mix_g, *ffn_g, *w_in, *q_a_g, *kv_a_g, *w_uq, *w_ukv, *q_g0, *k_g0, *conv_w, *w_out0,
      *w_qkv, *q_g1, *k_g1, *w_out1, *w1, *w3, *w2;
  float* out;
  char* ws;
  float* hmeta;
};

DI unsigned cvtpk(float lo, float hi) { f32x2 v = {lo, hi}; return __builtin_bit_cast(unsigned, __builtin_convertvector(v, bf16x2_t)); }
DI float bf_lo(unsigned u) { return __uint_as_float(u << 16); }
DI float bf_hi(unsigned u) { return __uint_as_float(u & 0xffff0000u); }
DI u16 f2bf(float x) { return (u16)(cvtpk(x, 0.f) & 0xffffu); }
DI int obid() { int b = blockIdx.x; asm volatile("" : "+s"(b)); return b; }
DI int otid(int wv) { int t; asm volatile("v_mbcnt_lo_u32_b32 %0, -1, 0\n\tv_mbcnt_hi_u32_b32 %0, -1, %0\n\tv_lshl_or_b32 %0, %1, 6, %0" : "=&v"(t) : "s"(wv)); return t; }
DI float wave_sum(float v) {
#pragma unroll
  for (int o = 32; o; o >>= 1) v += __shfl_xor(v, o);
  return v;
}
DI float sum16(float v) {
#pragma unroll
  for (int o = 8; o; o >>= 1) v += __shfl_xor(v, o);
  return v;
}
DI void unpack8(u32x4 v, float* f) {
#pragma unroll
  for (int i = 0; i < 4; ++i) { f[2 * i] = bf_lo(v[i]); f[2 * i + 1] = bf_hi(v[i]); }
}
DI u32x4 pack8(const float* f) { return u32x4{cvtpk(f[0], f[1]), cvtpk(f[2], f[3]), cvtpk(f[4], f[5]), cvtpk(f[6], f[7])}; }

DI const float* xrow(const Params& P, int t) {
  int s = t / L, p = t - s * L;
  if (p < NMETA) return P.meta + p * DM;
  const float* base = s < 8 ? P.xp + (size_t)(s * SEQ) * DM : P.xs + (size_t)((s - 8) * SEQ) * DM;
  return base + (size_t)(p - NMETA) * DM;
}
DI float* hrow(const Params& P, int t) {
  int s = t / L, p = t - s * L;
  if (p < NMETA) return P.hmeta + (s * NMETA + p) * DM;
  return P.out + ((size_t)s * SEQ + (p - NMETA)) * DM;
}

DI void transpose_job(const float* __restrict__ src, u16* __restrict__ dst, int K, int N, int mode, const float* __restrict__ gain, const int wv) {
  const int tid = otid(wv), lane = tid & 63, wave = tid >> 6;
  const int nkb = K / 32, nnb = N / 64;
  for (int ti = obid() * 8 + wave; ti < nkb * nnb; ti += gridDim.x * 8) {
    const int kb = ti / nnb, nb = ti - kb * nnb;
    const float* sp = src + (size_t)(kb * 32) * N + nb * 64 + lane;
    float v[32];
#pragma unroll
    for (int kk = 0; kk < 32; ++kk) v[kk] = sp[(size_t)kk * N];
    if (gain) {
#pragma unroll
      for (int kk = 0; kk < 32; ++kk) v[kk] *= gain[kb * 32 + kk];
    }
    const int n = nb * 64 + lane;
    int drow;
    if (mode == 4) {
      if (n < 1216) drow = n;
      else { const int c = (n - 1216) & 511, isu = (n >= 1728); drow = 1280 + (c >> 7) * 256 + isu * 128 + (c & 127); }
    } else drow = mode ? (n >> 7) * 256 + (mode - 1) * 128 + (n & 127) : n;
    u16* dp = dst + (size_t)drow * K + kb * 32;
#pragma unroll
    for (int q = 0; q < 4; ++q) *(u32x4*)(dp + q * 8) = pack8(&v[q * 8]);
  }
}

template <bool FROMX>
DI void norm_phase(const Params& P, const float* __restrict__ g, u16* __restrict__ hn, const int wv) {
  const int tid_ = otid(wv), wave = tid_ >> 6, lane = tid_ & 63;
  for (int t = obid() * 8 + wave; t < T; t += gridDim.x * 8) {
    const float* r = xrow(P, t);
    f32x4 v[4];
    float ss = 0.f;
#pragma unroll
    for (int j = 0; j < 4; ++j) {
      v[j] = *(const f32x4*)(r + j * 256 + lane * 4);
      ss += v[j][0] * v[j][0] + v[j][1] * v[j][1] + v[j][2] * v[j][2] + v[j][3] * v[j][3];
    }
    ss = wave_sum(ss);
    const float rs = rsqrtf(ss * (1.f / DM) + EPS);
#pragma unroll
    for (int j = 0; j < 4; ++j) {
      const f32x4 gg = *(const f32x4*)(g + j * 256 + lane * 4);
      u32x2 o = {cvtpk(v[j][0] * rs * gg[0], v[j][1] * rs * gg[1]), cvtpk(v[j][2] * rs * gg[2], v[j][3] * rs * gg[3])};
      *(u32x2*)(hn + (size_t)t * DM + j * 256 + lane * 4) = o;
    }
  }
}

namespace pg8 {
#define PG8_LAS __attribute__((address_space(3)))
constexpr int BM = 256, BKK = 64, HALF = 128, HTB = HALF * BKK * 2, STAGE_BYTES = 8 * HTB, NXCD = 8, WGM = 8;
DI int lds_byte(int r, int c) { const int st = (r >> 4) * 2 + (c >> 5), rr = r & 15, cc = c & 31, ob = rr * 64 + cc * 2; return st * 1024 + (ob ^ (((ob >> 9) & 1) << 5)); }
DI void stage_rc(int b, int& R, int& C) { const int st = b / 1024, sb = b % 1024, swz = sb ^ (((sb >> 9) & 1) << 5); R = (st >> 1) * 16 + swz / 64; C = (st & 1) * 32 + (swz % 64) / 2; }
DI int perm32(int rho) { const int n = rho >> 4, i = rho & 15; return 8 * (i >> 2) + 4 * n + (i & 3); }
struct Unit { int pm, pn; };
struct Gemm { const u16* A; const u16* Bt; int M, N, K; };
struct StaticOrder {
  int nM, nN, nwg, G, c;
  DI void init(int M, int N, int G_, int c_) { nM = M / BM; nN = N / BM; nwg = nM * nN; G = G_; c = c_; }
  DI bool next(int i, Unit& u) const {
    const long Lx = (long)i * G + c; if (__builtin_amdgcn_readfirstlane((int)(Lx >= nwg))) return false;
    int wgid = (int)Lx; { const int q = nwg / NXCD, r = nwg % NXCD, xcd = wgid % NXCD, off = wgid / NXCD; wgid = (xcd < r ? xcd * (q + 1) : r * (q + 1) + (xcd - r) * q) + off; }
    const int nig = WGM * nN, gid = wgid / nig, fm = gid * WGM, gsz = (nM - fm) < WGM ? (nM - fm) : WGM;
    u.pm = __builtin_amdgcn_readfirstlane(fm + ((wgid % nig) % gsz)); u.pn = __builtin_amdgcn_readfirstlane((wgid % nig) / gsz); return true;
  }
};
template <class Epi>
DI void gemm_phase(PG8_LAS unsigned char* lds, const Gemm g, const StaticOrder& S, const Epi& E, const int wv) {
  const int tid = otid(wv), wid = __builtin_amdgcn_readfirstlane(tid >> 6), lane = tid & 63, wr = wid >> 2, wc = wid & 3, fr = lane & 15, fq = lane >> 4;
  const int K = g.K, nt = K / BKK;
  unsigned voffA[2], voffB[2];
#pragma unroll
  for (int i = 0; i < 2; ++i) { int R, C; stage_rc(tid * 16 + i * 8192, R, C); const int Rb = (R & ~31) + perm32(R & 31);
    voffA[i] = (unsigned)(R * K + C) * 2u; voffB[i] = (unsigned)(Rb * K + C) * 2u; }
  const size_t kstep = (size_t)(BKK * 2);
  const size_t hstep = (size_t)HALF * K * 2;
  const size_t tstep = 2 * hstep;
  const unsigned ldsw = (unsigned)wid * 1024u;
  const int aoff = lds_byte(wr * 64 + fr, fq * 8), boff = lds_byte(wc * 32 + fr, fq * 8);
#define PG8_SA(b, h) (((b) * 2 + (h)) * HTB)
#define PG8_SB(b, h) ((4 + (b) * 2 + (h)) * HTB)
#define PG8_STAGE(bufoff, gbase, voff) do { _Pragma("unroll") for (int _i = 0; _i < 2; ++_i) \
    __builtin_amdgcn_global_load_lds((const unsigned*)((const char*)(gbase) + (voff)[_i]), (PG8_LAS unsigned*)(lds + (bufoff) + ldsw + _i * 8192), 16, 0, 0); } while (0)
#define PG8_LDA(dst, b, h) do { _Pragma("unroll") for (int m = 0; m < 4; ++m) _Pragma("unroll") for (int k = 0; k < 2; ++k) dst[m][k] = *(const PG8_LAS bf16x8*)(lds + PG8_SA(b, h) + aoff + m * 2048 + k * 1024); } while (0)
#define PG8_LDB(dst, b, h) do { _Pragma("unroll") for (int n = 0; n < 2; ++n) _Pragma("unroll") for (int k = 0; k < 2; ++k) dst[n][k] = *(const PG8_LAS bf16x8*)(lds + PG8_SB(b, h) + boff + n * 2048 + k * 1024); } while (0)
#define PG8_MMA(ai, bj, At, Bt) do { __builtin_amdgcn_s_setprio(1); _Pragma("unroll") for (int m = 0; m < 4; ++m) _Pragma("unroll") for (int n = 0; n < 2; ++n) _Pragma("unroll") for (int k = 0; k < 2; ++k) \
    acc[ai][bj][m][n] = __builtin_amdgcn_mfma_f32_16x16x32_bf16(Bt[n][k], At[m][k], acc[ai][bj][m][n], 0, 0, 0); __builtin_amdgcn_s_setprio(0); } while (0)
#define PG8_WAIT_V(n) asm volatile("s_waitcnt vmcnt(" #n ")" ::: "memory")
#define PG8_WAIT_L(n) asm volatile("s_waitcnt lgkmcnt(" #n ")" ::: "memory")
#define PG8_BAR __builtin_amdgcn_s_barrier()
#define PG8_SCHED __builtin_amdgcn_sched_barrier(0)
  Unit cur, nxt; int ui = 0;
  if (!S.next(0, cur)) return;
  f32x4 acc[2][2][4][2];
#pragma unroll
  for (int a = 0; a < 2; ++a)
#pragma unroll
    for (int b = 0; b < 2; ++b)
#pragma unroll
      for (int m = 0; m < 4; ++m)
#pragma unroll
        for (int n = 0; n < 2; ++n) acc[a][b][m][n] = (f32x4){0.f, 0.f, 0.f, 0.f};
  bf16x8 At[4][2], B0[2][2], B1[2][2];
  const char* cA = (const char*)g.A + (size_t)cur.pm * tstep; const char* cB = (const char*)g.Bt + (size_t)cur.pn * tstep;
  PG8_STAGE(PG8_SB(0, 0), cB, voffB); PG8_STAGE(PG8_SA(0, 0), cA, voffA); PG8_STAGE(PG8_SB(0, 1), cB + hstep, voffB); PG8_STAGE(PG8_SA(0, 1), cA + hstep, voffA);
  if (wr == 1) PG8_BAR;
  PG8_WAIT_V(4); PG8_BAR;
  PG8_STAGE(PG8_SB(1, 0), cB + kstep, voffB); PG8_STAGE(PG8_SA(1, 0), cA + kstep, voffA); PG8_STAGE(PG8_SB(1, 1), cB + hstep + kstep, voffB);
  PG8_WAIT_V(6); PG8_BAR;
  for (;;) {
    const bool has_next = S.next(ui + 1, nxt);
    const char* nA = has_next ? (const char*)g.A + (size_t)nxt.pm * tstep : cA; const char* nB = has_next ? (const char*)g.Bt + (size_t)nxt.pn * tstep : cB;
#pragma nounroll
    for (int t = 0; t < nt; t += 2) {
      const bool last = (t == nt - 2);
      const char* a1 = cA + (size_t)(t + 1) * kstep;
      const char* a2 = last ? nA : cA + (size_t)(t + 2) * kstep; const char* b2 = last ? nB : cB + (size_t)(t + 2) * kstep;
      const char* a3 = a2 + kstep; const char* b3 = b2 + kstep;
      PG8_LDB(B0, 0, 0); PG8_SCHED; PG8_LDA(At, 0, 0); PG8_STAGE(PG8_SA(1, 1), a1 + hstep, voffA);
      PG8_WAIT_L(8); PG8_BAR; PG8_WAIT_L(0); PG8_MMA(0, 0, At, B0); PG8_BAR; PG8_SCHED;
      PG8_LDB(B1, 0, 1); PG8_STAGE(PG8_SB(0, 0), b2, voffB);
      PG8_BAR; PG8_WAIT_L(0); PG8_MMA(0, 1, At, B1); PG8_BAR;
      PG8_LDA(At, 0, 1); PG8_STAGE(PG8_SA(0, 0), a2, voffA);
      PG8_BAR; PG8_WAIT_L(0); PG8_MMA(1, 0, At, B0); PG8_BAR; PG8_SCHED;
      PG8_STAGE(PG8_SB(0, 1), b2 + hstep, voffB);
      PG8_WAIT_V(6); PG8_BAR; PG8_MMA(1, 1, At, B1); PG8_BAR;
      PG8_LDB(B0, 1, 0); PG8_SCHED; PG8_LDA(At, 1, 0); PG8_STAGE(PG8_SA(0, 1), a2 + hstep, voffA);
      PG8_WAIT_L(8); PG8_BAR; PG8_WAIT_L(0); PG8_MMA(0, 0, At, B0); PG8_BAR; PG8_SCHED;
      PG8_LDB(B1, 1, 1); PG8_STAGE(PG8_SB(1, 0), b3, voffB);
      PG8_BAR; PG8_WAIT_L(0); PG8_MMA(0, 1, At, B1); PG8_BAR;
      PG8_LDA(At, 1, 1); PG8_STAGE(PG8_SA(1, 0), a3, voffA);
      PG8_BAR; PG8_WAIT_L(0); PG8_MMA(1, 0, At, B0); PG8_BAR; PG8_SCHED;
      PG8_STAGE(PG8_SB(1, 1), b3 + hstep, voffB);
      PG8_WAIT_V(6); PG8_BAR; PG8_MMA(1, 1, At, B1); PG8_BAR;
    }
    E(acc, cur, wr, wc, fr, fq);
    if (!has_next) break;
#pragma unroll
    for (int a = 0; a < 2; ++a)
#pragma unroll
      for (int b = 0; b < 2; ++b)
#pragma unroll
        for (int m = 0; m < 4; ++m)
#pragma unroll
          for (int n = 0; n < 2; ++n) acc[a][b][m][n] = (f32x4){0.f, 0.f, 0.f, 0.f};
    cur = nxt; cA = nA; cB = nB; ++ui;
  }
  PG8_WAIT_V(0);
  if (wr == 0) PG8_BAR;
  PG8_BAR;
#undef PG8_SA
#undef PG8_SB
#undef PG8_STAGE
#undef PG8_LDA
#undef PG8_LDB
#undef PG8_MMA
#undef PG8_WAIT_V
#undef PG8_WAIT_L
#undef PG8_BAR
#undef PG8_SCHED
}
}

constexpr int TQ = NSEQ * SEQ;
constexpr int TP = 98816;
constexpr int SMEM_BYTES = pg8::STAGE_BYTES + 16;
typedef const f32x4 (&AccRef)[2][2][4][2];
DI u32x4 pack8v(f32x4 a, f32x4 b) { return u32x4{cvtpk(a[0], a[1]), cvtpk(a[2], a[3]), cvtpk(b[0], b[1]), cvtpk(b[2], b[3])}; }

DI int vt_pos(int p) { return (p & ~12) | ((p & 4) << 1) | ((p & 8) >> 1); }
#define EPI_ROWS_BEGIN() \
  _Pragma("unroll") for (int ai = 0; ai < 2; ++ai) { if (u.pm * 256 + ai * 128 >= T) continue;
#define EPI_ROWS_END() }

struct EpiStore {
  u16* out; int ldc; int nvalid;
  DI void operator()(AccRef acc, const pg8::Unit& u, int wr, int wc, int fr, int fq) const {
    const int row0 = u.pm * 256 + wr * 64 + fr, col0 = u.pn * 256 + wc * 32 + 8 * fq;
    EPI_ROWS_BEGIN()
#pragma unroll
      for (int m = 0; m < 4; ++m) {
        u16* rp = out + (size_t)(row0 + ai * 128 + m * 16) * ldc + col0;
#pragma unroll
        for (int bj = 0; bj < 2; ++bj)
          if (col0 + bj * 128 < nvalid) *(u32x4*)(rp + bj * 128) = pack8v(acc[ai][bj][m][0], acc[ai][bj][m][1]);
      }
    EPI_ROWS_END()
  }
};
constexpr int ZLD = 1728;
struct EpiZ {
  u16* z;
  DI void operator()(AccRef acc, const pg8::Unit& u, int wr, int wc, int fr, int fq) const {
    const int row0 = u.pm * 256 + wr * 64 + fr;
    EPI_ROWS_BEGIN()
#pragma unroll
      for (int m = 0; m < 4; ++m) {
        u16* rp = z + (size_t)(row0 + ai * 128 + m * 16) * ZLD;
        if (u.pn < 5) {
          const int col0 = u.pn * 256 + wc * 32 + 8 * fq;
#pragma unroll
          for (int bj = 0; bj < 2; ++bj)
            if (col0 + bj * 128 < 1216) *(u32x4*)(rp + col0 + bj * 128) = pack8v(acc[ai][bj][m][0], acc[ai][bj][m][1]);
        } else {
          const int col0 = 1216 + (u.pn - 5) * 128 + wc * 32 + 8 * fq;
          *(u32x4*)(rp + col0) = pack8v(acc[ai][0][m][0] * acc[ai][1][m][0], acc[ai][0][m][1] * acc[ai][1][m][1]);
        }
      }
    EPI_ROWS_END()
  }
};
struct EpiKV0 {
  u16* kn; u16* vt;
  DI void operator()(AccRef acc, const pg8::Unit& u, int wr, int wc, int fr, int fq) const {
    const int row0 = u.pm * 256 + wr * 64 + fr, w0 = wc * 32 + 8 * fq, head = u.pn;
    EPI_ROWS_BEGIN()
#pragma unroll
      for (int m = 0; m < 4; ++m) {
        const int row = row0 + ai * 128 + m * 16;
        const int s = row / L, p = row - s * L;
        *(u32x4*)(kn + (size_t)row * 512 + head * 128 + w0) = pack8v(acc[ai][0][m][0], acc[ai][0][m][1]);
        u16* vp = vt + (size_t)((s * 4 + head) * 128 + w0) * LP + vt_pos(p);
#pragma unroll
        for (int n = 0; n < 2; ++n)
#pragma unroll
          for (int e = 0; e < 4; ++e) vp[(size_t)(4 * n + e) * LP] = f2bf(acc[ai][1][m][n][e]);
        asm volatile("" ::: "memory");
      }
    EPI_ROWS_END()
  }
};
struct EpiQKV1 {
  u16* qk; u16* vt; const float* ss;
  DI void operator()(AccRef acc, const pg8::Unit& u, int wr, int wc, int fr, int fq) const {
    const int row0 = u.pm * 256 + wr * 64 + fr, w0 = wc * 32 + 8 * fq;
    EPI_ROWS_BEGIN()
      float rs[4];
#pragma unroll
      for (int m = 0; m < 4; ++m) rs[m] = ss[row0 + ai * 128 + m * 16];
#pragma unroll
      for (int m = 0; m < 4; ++m) rs[m] = rsqrtf(rs[m] * (1.f / DM) + EPS);
#pragma unroll
      for (int m = 0; m < 4; ++m) {
        const int row = row0 + ai * 128 + m * 16;
        if (u.pn < 5) {
#pragma unroll
          for (int bj = 0; bj < 2; ++bj)
            *(u32x4*)(qk + (size_t)row * 1280 + u.pn * 256 + bj * 128 + w0) = pack8v(acc[ai][bj][m][0] * rs[m], acc[ai][bj][m][1] * rs[m]);
        } else {
          const int s = row / L, p = row - s * L;
#pragma unroll
          for (int bj = 0; bj < 2; ++bj) {
            u16* vp = vt + (size_t)((s * 2 + bj) * 128 + w0) * LP + vt_pos(p);
#pragma unroll
            for (int n = 0; n < 2; ++n)
#pragma unroll
              for (int e = 0; e < 4; ++e) vp[(size_t)(4 * n + e) * LP] = f2bf(acc[ai][bj][m][n][e] * rs[m]);
          }
          asm volatile("" ::: "memory");
        }
      }
    EPI_ROWS_END()
  }
};
template <int MODE>
struct EpiRes {
  Params P; const u16* hsrc; u16* hdst; float* ss;
  DI void operator()(AccRef acc, const pg8::Unit& u, int wr, int wc, int fr, int fq) const {
    const int row0 = u.pm * 256 + wr * 64 + fr, col0 = u.pn * 256 + wc * 32 + 8 * fq;
    EPI_ROWS_BEGIN()
      f32x4 r[4][2][2];
      if constexpr (MODE == 0) {
#pragma unroll
        for (int m = 0; m < 4; ++m) {
          const float* src = xrow(P, row0 + ai * 128 + m * 16) + col0;
#pragma unroll
          for (int bj = 0; bj < 2; ++bj) { r[m][bj][0] = *(const f32x4*)(src + bj * 128); r[m][bj][1] = *(const f32x4*)(src + bj * 128 + 4); }
        }
      } else {
        u32x4 rb[4][2];
#pragma unroll
        for (int m = 0; m < 4; ++m)
#pragma unroll
          for (int bj = 0; bj < 2; ++bj) {
            const int rr = row0 + ai * 128 + m * 16;
            const int sr = (MODE == 3) ? rr + NMETA * ((rr >> 12) + 1) : rr;
            rb[m][bj] = *(const u32x4*)(hsrc + (size_t)sr * DM + col0 + bj * 128);
          }
#pragma unroll
        for (int m = 0; m < 4; ++m)
#pragma unroll
          for (int bj = 0; bj < 2; ++bj) {
            r[m][bj][0] = f32x4{bf_lo(rb[m][bj][0]), bf_hi(rb[m][bj][0]), bf_lo(rb[m][bj][1]), bf_hi(rb[m][bj][1])};
            r[m][bj][1] = f32x4{bf_lo(rb[m][bj][2]), bf_hi(rb[m][bj][2]), bf_lo(rb[m][bj][3]), bf_hi(rb[m][bj][3])};
          }
      }
#pragma unroll
      for (int m = 0; m < 4; ++m) {
        const int row = row0 + ai * 128 + m * 16;
        if constexpr (MODE == 4) {
          float* dst = P.out + (size_t)row * DM + col0;
#pragma unroll
          for (int bj = 0; bj < 2; ++bj) {
            *(f32x4*)(dst + bj * 128) = r[m][bj][0] + acc[ai][bj][m][0];
            *(f32x4*)(dst + bj * 128 + 4) = r[m][bj][1] + acc[ai][bj][m][1];
          }
        } else if constexpr (MODE == 2) {
          const int s = row / L, p = row - s * L;
          if (p >= NMETA) {
            float* dst = P.out + ((size_t)s * SEQ + (p - NMETA)) * DM + col0;
#pragma unroll
            for (int bj = 0; bj < 2; ++bj) {
              *(f32x4*)(dst + bj * 128) = r[m][bj][0] + acc[ai][bj][m][0];
              *(f32x4*)(dst + bj * 128 + 4) = r[m][bj][1] + acc[ai][bj][m][1];
            }
          }
        } else {
          float s2 = 0.f;
#pragma unroll
          for (int bj = 0; bj < 2; ++bj) {
            const f32x4 r0 = r[m][bj][0] + acc[ai][bj][m][0], r1 = r[m][bj][1] + acc[ai][bj][m][1];
            *(u32x4*)(hdst + (size_t)row * DM + col0 + bj * 128) = pack8v(r0, r1);
            s2 += r0[0] * r0[0] + r0[1] * r0[1] + r0[2] * r0[2] + r0[3] * r0[3] + r1[0] * r1[0] + r1[1] * r1[1] + r1[2] * r1[2] + r1[3] * r1[3];
          }
          s2 += __shfl_xor(s2, 16);
          s2 += __shfl_xor(s2, 32);
          if (fq == 0) atomicAdd(ss + row, s2);
        }
      }
    EPI_ROWS_END()
  }
};
struct EpiSwiglu {
  u16* act; const float* ss;
  DI void operator()(AccRef acc, const pg8::Unit& u, int wr, int wc, int fr, int fq) const {
    const int row0 = u.pm * 256 + wr * 64 + fr, col0 = u.pn * 128 + wc * 32 + 8 * fq;
    EPI_ROWS_BEGIN()
      float rs[4];
#pragma unroll
      for (int m = 0; m < 4; ++m) rs[m] = ss[row0 + ai * 128 + m * 16];
#pragma unroll
      for (int m = 0; m < 4; ++m) rs[m] = rsqrtf(rs[m] * (1.f / DM) + EPS);
#pragma unroll
      for (int m = 0; m < 4; ++m) {
        const int row = row0 + ai * 128 + m * 16;
        const float ne = rs[m] * -1.4426950408889634f, r2 = rs[m] * rs[m];
        f32x4 y[2];
#pragma unroll
        for (int n = 0; n < 2; ++n)
#pragma unroll
          for (int e = 0; e < 4; ++e) {
            const float a = acc[ai][0][m][n][e], b = acc[ai][1][m][n][e];
            y[n][e] = a * b * r2 * __builtin_amdgcn_rcpf(1.f + __builtin_amdgcn_exp2f(a * ne));
          }
        *(u32x4*)(act + (size_t)row * FFN + col0) = pack8v(y[0], y[1]);
      }
    EPI_ROWS_END()
  }
};
template <class Epi>
DI void run_gemm(char* smem, const u16* A, const u16* Bt, int N, int K, const Epi& E, int shift, const int wv, const int M = TP) {
  pg8::Gemm g{A, Bt, M, N, K};
  pg8::StaticOrder S; S.init(M, N, (int)gridDim.x, (int)((obid() + shift) % gridDim.x));
  pg8::gemm_phase<Epi>((PG8_LAS unsigned char*)smem, g, S, E, wv);
}

DI void e1_phase(const Params& P, const u16* __restrict__ z, u16* __restrict__ cqn, u16* __restrict__ ckvn, u16* __restrict__ kr,
                 u16* __restrict__ mix, const int wv) {
  const int tid_ = otid(wv), wave = tid_ >> 6, lane = tid_ & 63;
  for (int t = obid() * 8 + wave; t < T; t += gridDim.x * 8) {
    const u16* zr = z + (size_t)t * ZLD;
    const int s = t / L, p = t - s * L;
    float f[8], o[8];
    {
      float ss = 0.f;
      if (lane < 48) { unpack8(*(const u32x4*)(zr + lane * 8), f);
#pragma unroll
        for (int e = 0; e < 8; ++e) ss += f[e] * f[e]; }
      ss = wave_sum(ss);
      const float r = rsqrtf(ss * (1.f / 384.f) + EPS);
      if (lane < 48) {
#pragma unroll
        for (int e = 0; e < 8; ++e) o[e] = f[e] * r * P.q_a_g[lane * 8 + e];
        *(u32x4*)(cqn + (size_t)t * 384 + lane * 8) = pack8(o);
      }
    }
    {
      float ss = 0.f;
      if (lane < 32) { unpack8(*(const u32x4*)(zr + 384 + lane * 8), f);
#pragma unroll
        for (int e = 0; e < 8; ++e) ss += f[e] * f[e]; }
      ss = wave_sum(ss);
      const float r = rsqrtf(ss * (1.f / 256.f) + EPS);
      if (lane < 32) {
#pragma unroll
        for (int e = 0; e < 8; ++e) o[e] = f[e] * r * P.kv_a_g[lane * 8 + e];
        *(u32x4*)(ckvn + (size_t)t * 256 + lane * 8) = pack8(o);
      }
    }
    if (lane < 8) *(u32x4*)(kr + (size_t)t * 64 + lane * 8) = *(const u32x4*)(zr + 640 + lane * 8);
    {
      const int c0 = lane * 8;
      float gb[8], a[8], cv[8];
      unpack8(*(const u32x4*)(zr + 704 + c0), gb);
      unpack8(*(const u32x4*)(zr + 1216 + c0), a);
#pragma unroll
      for (int e = 0; e < 8; ++e) cv[e] = P.conv_w[512 + c0 + e] * a[e];
      if (p > 0) {
        unpack8(*(const u32x4*)(zr - ZLD + 1216 + c0), a);
#pragma unroll
        for (int e = 0; e < 8; ++e) cv[e] += P.conv_w[c0 + e] * a[e];
      }
      if (p < L - 1) {
        unpack8(*(const u32x4*)(zr + ZLD + 1216 + c0), a);
#pragma unroll
        for (int e = 0; e < 8; ++e) cv[e] += P.conv_w[1024 + c0 + e] * a[e];
      }
#pragma unroll
      for (int e = 0; e < 8; ++e) o[e] = gb[e] * cv[e];
      *(u32x4*)(mix + (size_t)t * DM + 512 + c0) = pack8(o);
    }
  }
}

DI void zero_vt_pad(u16* vt, int rows, const int wv) {
  const u32x4 zz = {0u, 0u, 0u, 0u};
  for (int idx = obid() * NTHREADS + otid(wv); idx < rows * 6; idx += gridDim.x * NTHREADS) {
    const int row = idx / 6, c = idx - row * 6;
    *(u32x4*)(vt + (size_t)row * LP + L + c * 8) = zz;
  }
}

constexpr float LOG2_THETA = 13.287712379549449f;
constexpr float INV_2PI = 0.15915494309189535f;
DI void rope_sc(float pos, int j, float& sn, float& cs) {
  const float fr = exp2f(-(float)j * (LOG2_THETA / 32.f));
  float tr = pos * fr * INV_2PI;
  tr -= floorf(tr);
  sn = __builtin_amdgcn_sinf(tr);
  cs = __builtin_amdgcn_cosf(tr);
}

DI void e2_phase(const Params& P, const u16* __restrict__ qpre, const u16* __restrict__ knpre, const u16* __restrict__ kr,
                 u16* __restrict__ Qo, u16* __restrict__ Ko, const int wv) {
  const int tid_ = otid(wv), wave = tid_ >> 6, lane = tid_ & 63, hd = lane >> 4, i = lane & 15;
  for (int t = obid() * 8 + wave; t < T; t += gridDim.x * 8) {
    const int s = t / L, p = t - s * L;
    float sn[2], cs[2];
    rope_sc((float)p, 2 * i, sn[0], cs[0]); rope_sc((float)p, 2 * i + 1, sn[1], cs[1]);
#pragma unroll
    for (int which = 0; which < 2; ++which) {
      float nf[8], x1[2], x2[2];
      const float* gg = which ? P.k_g0 : P.q_g0;
      if (which == 0) {
        const u16* src = qpre + (size_t)t * 768 + hd * 192;
        unpack8(*(const u32x4*)(src + 8 * i), nf);
        const unsigned a = *(const unsigned*)(src + 128 + 2 * i), b = *(const unsigned*)(src + 160 + 2 * i);
        x1[0] = bf_lo(a); x1[1] = bf_hi(a); x2[0] = bf_lo(b); x2[1] = bf_hi(b);
      } else {
        unpack8(*(const u32x4*)(knpre + (size_t)t * 512 + hd * 128 + 8 * i), nf);
        const unsigned a = *(const unsigned*)(kr + (size_t)t * 64 + 2 * i), b = *(const unsigned*)(kr + (size_t)t * 64 + 32 + 2 * i);
        x1[0] = bf_lo(a); x1[1] = bf_hi(a); x2[0] = bf_lo(b); x2[1] = bf_hi(b);
      }
      float ss = x1[0] * x1[0] + x1[1] * x1[1] + x2[0] * x2[0] + x2[1] * x2[1];
#pragma unroll
      for (int e = 0; e < 8; ++e) ss += nf[e] * nf[e];
      ss = sum16(ss);
      const float r = rsqrtf(ss * (1.f / 192.f) + EPS);
#pragma unroll
      for (int e = 0; e < 8; ++e) nf[e] = nf[e] * r * gg[8 * i + e];
      float o1[2], o2[2];
#pragma unroll
      for (int e = 0; e < 2; ++e) {
        const float a = x1[e] * r * gg[128 + 2 * i + e], b = x2[e] * r * gg[160 + 2 * i + e];
        o1[e] = a * cs[e] - b * sn[e];
        o2[e] = b * cs[e] + a * sn[e];
      }
      if (which == 0) {
        constexpr float CQ = 0.07216878364870322f * 1.4426950408889634f;
#pragma unroll
        for (int e = 0; e < 8; ++e) nf[e] *= CQ;
        o1[0] *= CQ; o1[1] *= CQ; o2[0] *= CQ; o2[1] *= CQ;
      }
      u16* dst = (which ? Ko : Qo) + (size_t)t * 768 + hd * 192;
      *(u32x4*)(dst + 8 * i) = pack8(nf);
      *(unsigned*)(dst + 128 + 2 * i) = cvtpk(o1[0], o1[1]);
      *(unsigned*)(dst + 160 + 2 * i) = cvtpk(o2[0], o2[1]);
    }
  }
}

DI void e3_phase(const Params& P, const u16* __restrict__ qk, u16* __restrict__ Ko, const int wv) {
  const int tid_ = otid(wv), wave = tid_ >> 6, lane = tid_ & 63, i = lane & 15, kh = (lane >> 4) & 1, tsel = lane >> 5;
  for (int tb = (obid() * 8 + wave) * 2; tb < T; tb += gridDim.x * 16) {
    const int t = tb + tsel;
    const int s = t / L, p = t - s * L;
    float snr[2], csr[2], snc[2], csc[2];
    if (p >= NMETA) {
      const float row = (float)((p - NMETA) >> 6), col = (float)((p - NMETA) & 63);
      rope_sc(row, 2 * i, snr[0], csr[0]); rope_sc(row, 2 * i + 1, snr[1], csr[1]);
      rope_sc(col, 2 * i, snc[0], csc[0]); rope_sc(col, 2 * i + 1, snc[1], csc[1]);
    } else {
      snr[0] = snr[1] = snc[0] = snc[1] = 0.f; csr[0] = csr[1] = csc[0] = csc[1] = 1.f;
    }
    const u16* src = qk + (size_t)t * 1280 + 1024 + kh * 128;
    const float* gg = P.k_g1;
    const unsigned ua1 = *(const unsigned*)(src + 2 * i), ua2 = *(const unsigned*)(src + 32 + 2 * i);
    const unsigned ub1 = *(const unsigned*)(src + 64 + 2 * i), ub2 = *(const unsigned*)(src + 96 + 2 * i);
    float a1[2] = {bf_lo(ua1), bf_hi(ua1)}, a2[2] = {bf_lo(ua2), bf_hi(ua2)};
    float b1[2] = {bf_lo(ub1), bf_hi(ub1)}, b2[2] = {bf_lo(ub2), bf_hi(ub2)};
    float ss = a1[0] * a1[0] + a1[1] * a1[1] + a2[0] * a2[0] + a2[1] * a2[1] + b1[0] * b1[0] + b1[1] * b1[1] + b2[0] * b2[0] + b2[1] * b2[1];
    ss = sum16(ss);
    const float r = rsqrtf(ss * (1.f / 128.f) + EPS);
    float oa1[2], oa2[2], ob1[2], ob2[2];
#pragma unroll
    for (int e = 0; e < 2; ++e) {
      const float xa1 = a1[e] * r * gg[2 * i + e], xa2 = a2[e] * r * gg[32 + 2 * i + e];
      const float xb1 = b1[e] * r * gg[64 + 2 * i + e], xb2 = b2[e] * r * gg[96 + 2 * i + e];
      oa1[e] = xa1 * csr[e] - xa2 * snr[e]; oa2[e] = xa2 * csr[e] + xa1 * snr[e];
      ob1[e] = xb1 * csc[e] - xb2 * snc[e]; ob2[e] = xb2 * csc[e] + xb1 * snc[e];
    }
    u16* dst = Ko + (size_t)t * 256 + kh * 128;
    *(unsigned*)(dst + 2 * i) = cvtpk(oa1[0], oa1[1]);
    *(unsigned*)(dst + 32 + 2 * i) = cvtpk(oa2[0], oa2[1]);
    *(unsigned*)(dst + 64 + 2 * i) = cvtpk(ob1[0], ob1[1]);
    *(unsigned*)(dst + 96 + 2 * i) = cvtpk(ob2[0], ob2[1]);
  }
}

#define RAW_BAR() do { asm volatile("s_waitcnt lgkmcnt(0)" ::: "memory"); __builtin_amdgcn_s_barrier(); asm volatile("" ::: "memory"); } while (0)
DI float xhalf_max(float x) {
  auto rr = __builtin_amdgcn_permlane32_swap(__float_as_uint(x), __float_as_uint(x), false, false);
  return fmaxf(__uint_as_float(rr[0]), __uint_as_float(rr[1]));
}
DI float xhalf_sum(float x) {
  auto rr = __builtin_amdgcn_permlane32_swap(__float_as_uint(x), __float_as_uint(x), false, false);
  return __uint_as_float(rr[0]) + __uint_as_float(rr[1]);
}
template <int DQK, int NHQ, int NHKV, bool HAS_META>
DI void attn_phase(const u16* __restrict__ Q, const u16* __restrict__ K, const u16* __restrict__ Vt, u16* __restrict__ O, const float* __restrict__ qg, const float* __restrict__ kg, char* smem, const int wv) {
  constexpr int NS = DQK / 16, CH = DQK / 8, KSTR = DQK * 2 + 16, VSTR = 144;
  constexpr int KBYTES = 64 * KSTR, VBYTES = 128 * VSTR;
  constexpr int NKC = 64 * CH / NTHREADS;
  constexpr int NT = (L + 63) / 64;
  constexpr bool EARLY_FETCH = (DQK == 128);
  constexpr int LDK = NHKV * DQK;
  static_assert(2 * (KBYTES + VBYTES) <= SMEM_BYTES, "attention LDS");
  const int tid = otid(wv), lane = tid & 63, wave = __builtin_amdgcn_readfirstlane(tid >> 6), r32 = lane & 31, hh = lane >> 5, grp = wave >> 2;
  constexpr int NF = NSEQ * NHQ * 16, nItems = NF + (HAS_META ? NSEQ * NHQ : 0);
#define A_DECODE(it_, hq_, sq_, q0_, ql_) do { if ((it_) < NF) { hq_ = ((it_) >> 4) % NHQ; sq_ = (it_) / (16 * NHQ); q0_ = NMETA + 256 * ((it_) & 15); ql_ = L; } \
    else { const int tt_ = (it_) - NF; hq_ = tt_ % NHQ; sq_ = tt_ / NHQ; q0_ = 0; ql_ = NMETA; } } while (0)
  char* kb0 = smem; char* vb0 = smem + 2 * KBYTES;
  const int lkey = tid >> 3, lc8 = tid & 7;
  const unsigned koff = (unsigned)(lkey * LDK * 2 + lc8 * 16);
  const unsigned koffL = (unsigned)(min(lkey, 15) * LDK * 2 + lc8 * 16);
  const unsigned voff = (unsigned)((lkey * LP + lc8 * 8) * 2);
  const unsigned kwoff = (unsigned)(lkey * KSTR + lc8 * 16), vwoff = (unsigned)(lkey * VSTR + lc8 * 16);
  const int G_ = (int)gridDim.x, b_ = obid();
  int item = (G_ % 8 == 0) ? (b_ % 8) * (G_ / 8) + b_ / 8 : b_;
  if (item >= nItems) return;
  u32x4 rk[NKC], rv[2];
#define A_LOADK(Kb_, tile_) do { const char* kp_ = (const char*)(Kb_) + (size_t)(tile_) * (64 * LDK * 2); const unsigned ko_ = ((tile_) == NT - 1) ? koffL : koff; \
    _Pragma("unroll") for (int i_ = 0; i_ < NKC; ++i_) rk[i_] = *(const u32x4*)(kp_ + ko_ + i_ * 128); } while (0)
#define A_LOADV(Vb_, tile_) do { const char* vp_ = (const char*)(Vb_) + (size_t)(tile_) * 128; \
    rv[0] = *(const u32x4*)(vp_ + voff); rv[1] = *(const u32x4*)(vp_ + voff + 64 * LP * 2); } while (0)
#define A_WRITEK(bi_) do { char* b_ = kb0 + (bi_) * KBYTES + kwoff; \
    _Pragma("unroll") for (int i_ = 0; i_ < NKC; ++i_) *(u32x4*)(b_ + i_ * 128) = rk[i_]; } while (0)
#define A_WRITEV(bi_) do { char* b_ = vb0 + (bi_) * VBYTES + vwoff; \
    *(u32x4*)(b_) = rv[0]; *(u32x4*)(b_ + 64 * VSTR) = rv[1]; } while (0)
#define A_FETCH(j_) do { \
        if ((j_) + 3 < NT) A_LOADK(Kb, (j_) + 3); \
        else if ((j_) == NT - 3 && has_next) A_LOADK(nKb, 0); \
        else if ((j_) == NT - 1 && has_next) A_LOADK(nKb, 1); \
        if ((j_) + 2 < NT) A_LOADV(Vb, (j_) + 2); \
        else if ((j_) == NT - 2 && has_next) A_LOADV(nVb, 0); } while (0)
#define A_QK(bi_) do { const char* sk_ = kb0 + (bi_) * KBYTES + r32 * KSTR + hh * 16; \
    _Pragma("unroll") for (int i_ = 0; i_ < 16; ++i_) { s0[i_] = 0.f; s1[i_] = 0.f; } \
    _Pragma("unroll") for (int i_ = 0; i_ < NS; ++i_) { \
      const bf16x8 k0f_ = *(const bf16x8*)(sk_ + i_ * 32); const bf16x8 k1f_ = *(const bf16x8*)(sk_ + 32 * KSTR + i_ * 32); \
      s0 = __builtin_amdgcn_mfma_f32_32x32x16_bf16(k0f_, qf[i_], s0, 0, 0, 0); \
      s1 = __builtin_amdgcn_mfma_f32_32x32x16_bf16(k1f_, qf[i_], s1, 0, 0, 0); } } while (0)
  int hq, sq, q0, qlim;
  A_DECODE(item, hq, sq, q0, qlim);
  const u16* Kb = K + (size_t)(sq * L) * LDK + (hq / (NHQ / NHKV)) * DQK;
  const u16* Vb = Vt + (size_t)((sq * NHKV + hq / (NHQ / NHKV)) * 128) * LP;
  A_LOADK(Kb, 0); A_WRITEK(0); A_LOADK(Kb, 1); A_LOADV(Vb, 0);
  if (grp == 1) { RAW_BAR(); }
  RAW_BAR();
  float l;
  f32x16 o[4], s0, s1;
  bf16x8 qf[NS], pb[4];
  for (;;) {
    const int pq = q0 + wave * 32 + r32;
    const bool valid = pq < qlim;
    const bool active = (item < NF) || (wave == 0);
    {
      const u16* qrow = Q + (size_t)(sq * L + (valid ? pq : qlim - 1)) * (NHQ * DQK) + hq * DQK + hh * 8;
#pragma unroll
      for (int i = 0; i < NS; ++i) qf[i] = *(const bf16x8*)(qrow + 16 * i);
    }
    l = 0.f;
#pragma unroll
    for (int d = 0; d < 4; ++d)
#pragma unroll
      for (int i = 0; i < 16; ++i) o[d][i] = 0.f;
    const int nitem = item + (int)gridDim.x;
    const bool has_next = nitem < nItems;
    int nhq, nsq, nq0, nqlim;
    A_DECODE(nitem, nhq, nsq, nq0, nqlim);
    const u16* nKb = K + (size_t)(nsq * L) * LDK + (nhq / (NHQ / NHKV)) * DQK;
    const u16* nVb = Vt + (size_t)((nsq * NHKV + nhq / (NHQ / NHKV)) * 128) * LP;
    RAW_BAR();
    A_WRITEK(1); A_WRITEV(0);
    __builtin_amdgcn_sched_barrier(0);
    if (active) A_QK(0);
    __builtin_amdgcn_sched_barrier(0);
    A_LOADK(Kb, 2); A_LOADV(Vb, 1);
    RAW_BAR();
    for (int j = 0; j < NT; ++j) {
      __builtin_amdgcn_s_setprio(0);
      if (active) {
        f32x2 ps2 = {0.f, 0.f};
        unsigned w_[16];
#pragma unroll
        for (int i = 0; i < 8; ++i) {
          f32x2 v;
          v[0] = __builtin_amdgcn_exp2f(s0[2 * i]); v[1] = __builtin_amdgcn_exp2f(s0[2 * i + 1]);
          if (j == NT - 1 && i >= 4) v = f32x2{0.f, 0.f};
          ps2 += v;
          w_[i] = cvtpk(v[0], v[1]);
        }
#pragma unroll
        for (int i = 0; i < 8; ++i) {
          f32x2 v;
          v[0] = __builtin_amdgcn_exp2f(s1[2 * i]); v[1] = __builtin_amdgcn_exp2f(s1[2 * i + 1]);
          if (j == NT - 1) v = f32x2{0.f, 0.f};
          ps2 += v;
          w_[8 + i] = cvtpk(v[0], v[1]);
        }
        l += xhalf_sum(ps2[0] + ps2[1]);
        pb[0] = __builtin_bit_cast(bf16x8, u32x4{w_[0], w_[1], w_[2], w_[3]});
        pb[1] = __builtin_bit_cast(bf16x8, u32x4{w_[4], w_[5], w_[6], w_[7]});
        pb[2] = __builtin_bit_cast(bf16x8, u32x4{w_[8], w_[9], w_[10], w_[11]});
        pb[3] = __builtin_bit_cast(bf16x8, u32x4{w_[12], w_[13], w_[14], w_[15]});
      }
      __builtin_amdgcn_s_setprio(2);
      RAW_BAR();
      if (j + 2 < NT) A_WRITEK(j & 1);
      else if (j == NT - 1 && has_next) A_WRITEK(0);
      if (j + 1 < NT) A_WRITEV((j + 1) & 1);
      __builtin_amdgcn_sched_barrier(0);
      if constexpr (EARLY_FETCH) { A_FETCH(j); __builtin_amdgcn_sched_barrier(0); }
        if (active && j == NT - 1) {
        const char* svl = vb0 + (j & 1) * VBYTES + r32 * VSTR + hh * 16;
        bf16x8 vf[4];
#pragma unroll
        for (int d = 0; d < 4; ++d) vf[d] = *(const bf16x8*)(svl + d * 32 * VSTR);
#pragma unroll
        for (int d = 0; d < 4; ++d) o[d] = __builtin_amdgcn_mfma_f32_32x32x16_bf16(vf[d], pb[0], o[d], 0, 0, 0);
      } else if (active)
      {
        constexpr int NQK = 2 * NS, NM = NQK + 16, RING = (DQK == 128) ? 8 : 6;
        const char* sk = kb0 + ((j + 1) & 1) * KBYTES + r32 * KSTR + hh * 16;
        const char* sv = vb0 + (j & 1) * VBYTES + r32 * VSTR + hh * 16;
        bf16x8 ring[RING];
#define A_FRAG(dst_, i_) do { if ((i_) < NQK) { dst_ = *(const bf16x8*)(sk + ((i_) & 1) * (32 * KSTR) + ((i_) >> 1) * 32); } \
          else { dst_ = *(const bf16x8*)(sv + (((i_) - NQK) & 3) * (32 * VSTR) + (((i_) - NQK) >> 2) * 32); } } while (0)
#pragma unroll
        for (int i = 0; i < 16; ++i) { s0[i] = 0.f; s1[i] = 0.f; }
#pragma unroll
        for (int i = 0; i < RING; ++i) A_FRAG(ring[i], i);
#pragma unroll
        for (int i = 0; i < NM; ++i) {
          if (i < NQK) {
            if (i & 1) s1 = __builtin_amdgcn_mfma_f32_32x32x16_bf16(ring[i % RING], qf[i >> 1], s1, 0, 0, 0);
            else       s0 = __builtin_amdgcn_mfma_f32_32x32x16_bf16(ring[i % RING], qf[i >> 1], s0, 0, 0, 0);
          } else {
            o[(i - NQK) & 3] = __builtin_amdgcn_mfma_f32_32x32x16_bf16(ring[i % RING], pb[(i - NQK) >> 2], o[(i - NQK) & 3], 0, 0, 0);
          }
          if (i + RING < NM) A_FRAG(ring[i % RING], i + RING);
          __builtin_amdgcn_sched_barrier(0);
        }
#undef A_FRAG
      }
        __builtin_amdgcn_sched_barrier(0);
      if constexpr (!EARLY_FETCH) A_FETCH(j);
      if (j == NT - 1 && valid) {
        const float inv = 1.f / l;
        u16* orow = O + (size_t)(HAS_META ? sq * L + pq : sq * SEQ + pq - NMETA) * DM + hq * 128 + hh * 4;
#pragma unroll
        for (int d = 0; d < 4; ++d)
#pragma unroll
          for (int q = 0; q < 4; ++q) {
            u32x2 w = {cvtpk(o[d][4 * q] * inv, o[d][4 * q + 1] * inv), cvtpk(o[d][4 * q + 2] * inv, o[d][4 * q + 3] * inv)};
            *(u32x2*)(orow + d * 32 + q * 8) = w;
          }
      }
      RAW_BAR();
    }
    if (!has_next) break;
    item = nitem; hq = nhq; sq = nsq; q0 = nq0; qlim = nqlim; Kb = nKb; Vb = nVb;
  }
  __builtin_amdgcn_s_setprio(0);
  if (grp == 0) RAW_BAR();
  RAW_BAR();
#undef A_LOADK
#undef A_LOADV
#undef A_WRITEK
#undef A_WRITEV
#undef A_QK
#undef A_FETCH
#undef A_DECODE
}

template <int NHQ, int NHKV>
DI void attn_phase_l1(const u16* __restrict__ Q, const u16* __restrict__ K, const u16* __restrict__ Vt, u16* __restrict__ O, const float* __restrict__ qg, char* smem, const int wv) {
  constexpr int DQK = 128, NS = 8, KSTR = DQK * 2 + 16, VSTR = 144;
  constexpr int KBYTES = 64 * KSTR, VBYTES = 128 * VSTR;
  constexpr int NKC = 2;
  constexpr int NT = (L + 63) / 64;
  constexpr int LDK = NHKV * DQK;
  constexpr int NF = NSEQ * NHQ * 16;
  const int tid = otid(wv), lane = tid & 63, wave = __builtin_amdgcn_readfirstlane(tid >> 6), r32 = lane & 31, hh = lane >> 5;
  char* kb0 = smem; char* vb0 = smem + 2 * KBYTES;
  const int lkey = tid >> 3, lc8 = tid & 7;
  const unsigned koff = (unsigned)(lkey * LDK * 2 + lc8 * 16);
  const unsigned koffL = (unsigned)(min(lkey, 15) * LDK * 2 + lc8 * 16);
  const unsigned voff = (unsigned)((lkey * LP + lc8 * 8) * 2);
  const unsigned kwoff = (unsigned)(lkey * KSTR + lc8 * 16), vwoff = (unsigned)(lkey * VSTR + lc8 * 16);
  const int G_ = (int)gridDim.x, b_ = obid();
  u32x4 rk[NKC], rv[2];
#define B_LOADK(Kb_, tile_) do { const char* kp_ = (const char*)(Kb_) + (size_t)(tile_) * (64 * LDK * 2); const unsigned ko_ = ((tile_) == NT - 1) ? koffL : koff; \
    _Pragma("unroll") for (int i_ = 0; i_ < NKC; ++i_) rk[i_] = *(const u32x4*)(kp_ + ko_ + i_ * 128); } while (0)
#define B_LOADV(Vb_, tile_) do { const char* vp_ = (const char*)(Vb_) + (size_t)(tile_) * 128; \
    rv[0] = *(const u32x4*)(vp_ + voff); rv[1] = *(const u32x4*)(vp_ + voff + 64 * LP * 2); } while (0)
#define B_WRITEK(bi_) do { char* b_w = kb0 + (bi_) * KBYTES + kwoff; \
    _Pragma("unroll") for (int i_ = 0; i_ < NKC; ++i_) *(u32x4*)(b_w + i_ * 128) = rk[i_]; } while (0)
#define B_WRITEV(bi_) do { char* b_w = vb0 + (bi_) * VBYTES + vwoff; \
    *(u32x4*)(b_w) = rv[0]; *(u32x4*)(b_w + 64 * VSTR) = rv[1]; } while (0)
  f32x16 o[4], s0, s1;
  bf16x8 qf[NS], pb[4];
  for (int item = (G_ % 8 == 0) ? (b_ % 8) * (G_ / 8) + b_ / 8 : b_; item < NF; item += G_) {
    const int hq = (item >> 4) % NHQ, sq = item / (16 * NHQ), q0 = NMETA + 256 * (item & 15);
    const u16* Kb = K + (size_t)(sq * L) * LDK + (hq / (NHQ / NHKV)) * DQK;
    const u16* Vb = Vt + (size_t)((sq * NHKV + hq / (NHQ / NHKV)) * 128) * LP;
    const int pq = q0 + wave * 32 + r32;
    {
      const u16* qrow = Q + (size_t)(sq * L + pq) * 1280 + hq * DQK + hh * 8;
      int hho = hh; asm volatile("" : "+v"(hho));
      float ssq = 0.f;
#pragma unroll
      for (int i = 0; i < NS; ++i) {
        qf[i] = *(const bf16x8*)(qrow + 16 * i);
        float t8[8]; unpack8(__builtin_bit_cast(u32x4, qf[i]), t8);
#pragma unroll
        for (int e = 0; e < 8; ++e) ssq += t8[e] * t8[e];
      }
      ssq = xhalf_sum(ssq);
      const float rn = rsqrtf(ssq * (1.f / DQK) + EPS) * (0.08838834764831845f * 1.4426950408889634f);
#define A_QSCALE(dst_, i_) do { unpack8(__builtin_bit_cast(u32x4, qf[i_]), dst_); \
        const f32x4 g0_ = *(const f32x4*)(qg + 16 * (i_) + 8 * hh), g1_ = *(const f32x4*)(qg + 16 * (i_) + 8 * hh + 4); \
        _Pragma("unroll") for (int e_ = 0; e_ < 4; ++e_) { dst_[e_] *= rn * g0_[e_]; dst_[4 + e_] *= rn * g1_[e_]; } } while (0)
#define A_QROPE(ia_, ib_, jb_, pos_) do { float xa_[8], xb_[8]; A_QSCALE(xa_, ia_); A_QSCALE(xb_, ib_); \
        _Pragma("unroll") for (int e_ = 0; e_ < 8; ++e_) { float sn_, cs_; rope_sc(pos_, 16 * (jb_) + 8 * hho + e_, sn_, cs_); \
          const float a_ = xa_[e_], b_ = xb_[e_]; xa_[e_] = a_ * cs_ - b_ * sn_; xb_[e_] = b_ * cs_ + a_ * sn_; } \
        qf[ia_] = __builtin_bit_cast(bf16x8, pack8(xa_)); qf[ib_] = __builtin_bit_cast(bf16x8, pack8(xb_)); } while (0)
      const float prow = (float)((pq - NMETA) >> 6), pcol = (float)((pq - NMETA) & 63);
      A_QROPE(0, 2, 0, prow); A_QROPE(1, 3, 1, prow);
      A_QROPE(4, 6, 0, pcol); A_QROPE(5, 7, 1, pcol);
#undef A_QROPE
#undef A_QSCALE
    }
    float l = 0.f;
#pragma unroll
    for (int d = 0; d < 4; ++d)
#pragma unroll
      for (int i = 0; i < 16; ++i) o[d][i] = 0.f;
    __syncthreads();
    B_LOADK(Kb, 0); B_WRITEK(0); B_LOADK(Kb, 1); B_WRITEK(1); B_LOADV(Vb, 0); B_WRITEV(0);
    B_LOADK(Kb, 2); B_LOADV(Vb, 1);
    __syncthreads();
    {
      const char* sk = kb0 + r32 * KSTR + hh * 16;
#pragma unroll
      for (int i = 0; i < 16; ++i) { s0[i] = 0.f; s1[i] = 0.f; }
#pragma unroll
      for (int i = 0; i < NS; ++i) {
        const bf16x8 k0f = *(const bf16x8*)(sk + i * 32), k1f = *(const bf16x8*)(sk + 32 * KSTR + i * 32);
        s0 = __builtin_amdgcn_mfma_f32_32x32x16_bf16(k0f, qf[i], s0, 0, 0, 0);
        s1 = __builtin_amdgcn_mfma_f32_32x32x16_bf16(k1f, qf[i], s1, 0, 0, 0);
      }
      unsigned w_[16]; f32x2 ps2 = {0.f, 0.f};
#pragma unroll
      for (int i = 0; i < 8; ++i) { f32x2 v; v[0] = __builtin_amdgcn_exp2f(s0[2 * i]); v[1] = __builtin_amdgcn_exp2f(s0[2 * i + 1]); ps2 += v; w_[i] = cvtpk(v[0], v[1]); }
#pragma unroll
      for (int i = 0; i < 8; ++i) { f32x2 v; v[0] = __builtin_amdgcn_exp2f(s1[2 * i]); v[1] = __builtin_amdgcn_exp2f(s1[2 * i + 1]); ps2 += v; w_[8 + i] = cvtpk(v[0], v[1]); }
      l += ps2[0] + ps2[1];
#pragma unroll
      for (int q = 0; q < 4; ++q) pb[q] = __builtin_bit_cast(bf16x8, u32x4{w_[4 * q], w_[4 * q + 1], w_[4 * q + 2], w_[4 * q + 3]});
    }
    asm volatile("s_waitcnt lgkmcnt(0)" ::: "memory"); __builtin_amdgcn_s_barrier(); asm volatile("" ::: "memory");
    for (int j = 0; j < NT; ++j) {
      if (j + 2 < NT) B_WRITEK(j & 1);
      if (j + 1 < NT) B_WRITEV((j + 1) & 1);
      __builtin_amdgcn_sched_barrier(0);
      if (j + 3 < NT) B_LOADK(Kb, j + 3);
      if (j + 2 < NT) B_LOADV(Vb, j + 2);
      __builtin_amdgcn_sched_barrier(0);
      if (j == NT - 1) {
        const char* svl = vb0 + (j & 1) * VBYTES + r32 * VSTR + hh * 16;
        bf16x8 vf[4];
#pragma unroll
        for (int d = 0; d < 4; ++d) vf[d] = *(const bf16x8*)(svl + d * 32 * VSTR);
#pragma unroll
        for (int d = 0; d < 4; ++d) o[d] = __builtin_amdgcn_mfma_f32_32x32x16_bf16(vf[d], pb[0], o[d], 0, 0, 0);
      } else {
        constexpr int NQK = 2 * NS, NM = NQK + 16, RING = 8;
        const char* sk = kb0 + ((j + 1) & 1) * KBYTES + r32 * KSTR + hh * 16;
        const char* sv = vb0 + (j & 1) * VBYTES + r32 * VSTR + hh * 16;
        bf16x8 ring[RING];
        unsigned w_[16]; f32x2 ps2 = {0.f, 0.f};
#define B_FRAG(dst_, i_) do { if ((i_) < NQK) { dst_ = *(const bf16x8*)(sk + ((i_) & 1) * (32 * KSTR) + ((i_) >> 1) * 32); } \
          else { dst_ = *(const bf16x8*)(sv + (((i_) - NQK) & 3) * (32 * VSTR) + (((i_) - NQK) >> 2) * 32); } } while (0)
#pragma unroll
        for (int i = 0; i < 16; ++i) { s0[i] = 0.f; s1[i] = 0.f; }
#pragma unroll
        for (int i = 0; i < RING; ++i) B_FRAG(ring[i], i);
#pragma unroll
        for (int i = 0; i < NM; ++i) {
          if (i < NQK) {
            if (i & 1) s1 = __builtin_amdgcn_mfma_f32_32x32x16_bf16(ring[i % RING], qf[i >> 1], s1, 0, 0, 0);
            else       s0 = __builtin_amdgcn_mfma_f32_32x32x16_bf16(ring[i % RING], qf[i >> 1], s0, 0, 0, 0);
          } else {
            o[(i - NQK) & 3] = __builtin_amdgcn_mfma_f32_32x32x16_bf16(ring[i % RING], pb[(i - NQK) >> 2], o[(i - NQK) & 3], 0, 0, 0);
          }
          if (i + RING < NM) B_FRAG(ring[i % RING], i + RING);
          if (i >= NQK + 2) {
            const int g = i - NQK - 2;
            f32x2 v;
            if (g < 8) { v[0] = __builtin_amdgcn_exp2f(s0[2 * g]); v[1] = __builtin_amdgcn_exp2f(s0[2 * g + 1]); }
            else       { v[0] = __builtin_amdgcn_exp2f(s1[2 * (g - 8)]); v[1] = __builtin_amdgcn_exp2f(s1[2 * (g - 8) + 1]); }
            ps2 += v; w_[g] = cvtpk(v[0], v[1]);
          }
          __builtin_amdgcn_sched_barrier(0);
        }
#pragma unroll
        for (int g = 14; g < 16; ++g) { f32x2 v; v[0] = __builtin_amdgcn_exp2f(s1[2 * (g - 8)]); v[1] = __builtin_amdgcn_exp2f(s1[2 * (g - 8) + 1]); ps2 += v; w_[g] = cvtpk(v[0], v[1]); }
#undef B_FRAG
        if (j + 1 == NT - 1) {
          ps2 = f32x2{0.f, 0.f};
#pragma unroll
          for (int g = 0; g < 4; ++g) { ps2[0] += __builtin_amdgcn_exp2f(s0[2 * g]); ps2[1] += __builtin_amdgcn_exp2f(s0[2 * g + 1]); }
#pragma unroll
          for (int g = 4; g < 16; ++g) w_[g] = 0u;
        }
        if (j + 1 < NT) {
          l += ps2[0] + ps2[1];
#pragma unroll
          for (int q = 0; q < 4; ++q) pb[q] = __builtin_bit_cast(bf16x8, u32x4{w_[4 * q], w_[4 * q + 1], w_[4 * q + 2], w_[4 * q + 3]});
        }
      }
      asm volatile("s_waitcnt lgkmcnt(0)" ::: "memory"); __builtin_amdgcn_s_barrier(); asm volatile("" ::: "memory");
    }
    {
      const float inv = 1.f / xhalf_sum(l);
      u16* orow = O + (size_t)(sq * SEQ + pq - NMETA) * DM + hq * 128 + hh * 4;
#pragma unroll
      for (int d = 0; d < 4; ++d)
#pragma unroll
        for (int q = 0; q < 4; ++q) {
          u32x2 w = {cvtpk(o[d][4 * q] * inv, o[d][4 * q + 1] * inv), cvtpk(o[d][4 * q + 2] * inv, o[d][4 * q + 3] * inv)};
          *(u32x2*)(orow + d * 32 + q * 8) = w;
        }
    }
  }
  __syncthreads();
#undef B_LOADK
#undef B_LOADV
#undef B_WRITEK
#undef B_WRITEV
}

#define XB_TMO      128
#define XB_XCNT(j)  (256  + 64 * (j))
#define XB_XSUB(j)  (1280 + 64 * (j))
#define XB_XGEN(j)  (2304 + 64 * (j))
#define XB_TOP      3328
#define XB_TOPGEN   3392
#define XCD_BAR_WORDS 3456
#define XB_SPIN_CAP (1u << 18)
#define LAS3 __attribute__((address_space(3)))
DI unsigned xb_ld(unsigned* p) { return __hip_atomic_load(p, __ATOMIC_RELAXED, __HIP_MEMORY_SCOPE_AGENT); }
DI unsigned xb_add(unsigned* p, unsigned v) { return __hip_atomic_fetch_add(p, v, __ATOMIC_RELAXED, __HIP_MEMORY_SCOPE_AGENT); }
DI unsigned xb_xcc_id() { return (unsigned)__builtin_amdgcn_s_getreg((3 << 11) | 20) & 0xFu; }
#define XB_SPIN(cond, bar) do { unsigned _sp = 0; while (cond) { __builtin_amdgcn_s_sleep(1); \
    if ((++_sp & 255u) == 0u) { if (xb_ld(&(bar)[XB_TMO])) break; if (_sp > XB_SPIN_CAP) { atomicAdd(&(bar)[XB_TMO], 1u); break; } } } } while (0)
struct XcdBarrier { unsigned* bar; unsigned x; volatile LAS3 unsigned* st; };
DI XcdBarrier xcd_barrier_post(unsigned* bar, volatile LAS3 unsigned* st) {
  XcdBarrier b; b.bar = bar; b.x = xb_xcc_id(); b.st = st;
  if (threadIdx.x == 0) (void)xb_add(&bar[XB_XCNT(b.x)], 1u);
  return b;
}
DI void xcd_barrier_complete(unsigned* bar, unsigned x, unsigned& nloc, unsigned& nx) {
  const unsigned G = gridDim.x * gridDim.y * gridDim.z;
  unsigned sum, cnt, mine, sp = 0u;
  for (;;) {
    sum = 0u; cnt = 0u; mine = 0u;
#pragma unroll
    for (unsigned j = 0; j < 16; ++j) { const unsigned c = xb_ld(&bar[XB_XCNT(j)]); sum += c; cnt += (c > 0u) ? 1u : 0u; mine = (j == x) ? c : mine; }
    if (sum == G) break;
    __builtin_amdgcn_s_sleep(1);
    if ((++sp & 255u) == 0u) { if (xb_ld(&bar[XB_TMO])) break; if (sp > XB_SPIN_CAP) { atomicAdd(&bar[XB_TMO], 1u); break; } }
  }
  nloc = mine > 0u ? mine : 1u; nx = cnt > 0u ? cnt : 1u;
}
DI void xcd_barrier(unsigned* bar, const unsigned x, volatile LAS3 unsigned* st) {
  asm volatile("s_waitcnt vmcnt(0)" ::: "memory");
  __syncthreads();
  if (threadIdx.x == 0) {
    __builtin_amdgcn_s_waitcnt(0);
    unsigned nloc = st[0], nx = st[1];
    if (nloc == 0u) { xcd_barrier_complete(bar, x, nloc, nx); st[0] = nloc; st[1] = nx; }
    const unsigned old = xb_add(&bar[XB_XSUB(x)], 1u);
    const unsigned gen = old / nloc;
    if (old + 1u == (gen + 1u) * nloc) {
      __builtin_amdgcn_fence(__ATOMIC_RELEASE, "agent");
      asm volatile("s_waitcnt vmcnt(0)" ::: "memory");
      const unsigned og = xb_add(&bar[XB_TOP], 1u);
      const unsigned tg = og / nx;
      if (og + 1u == (tg + 1u) * nx) xb_add(&bar[XB_TOPGEN], 1u);
      else XB_SPIN(xb_ld(&bar[XB_TOPGEN]) == tg, bar);
      __builtin_amdgcn_fence(__ATOMIC_ACQUIRE, "agent");
      xb_add(&bar[XB_XGEN(x)], 1u);
      asm volatile("s_waitcnt vmcnt(0)" ::: "memory");
    } else {
      XB_SPIN(xb_ld(&bar[XB_XGEN(x)]) == gen, bar);
      __builtin_amdgcn_fence(__ATOMIC_ACQUIRE, "agent");
      asm volatile("s_waitcnt vmcnt(0)" ::: "memory");
    }
  }
  __syncthreads();
}
constexpr size_t O_BAR = 47 * MiB + 512 * 1024;

template <class Tp> DI Tp* uni(Tp* p) {
  const unsigned long long v = (unsigned long long)p;
  const unsigned lo = __builtin_amdgcn_readfirstlane((unsigned)v), hi = __builtin_amdgcn_readfirstlane((unsigned)(v >> 32));
  typedef __attribute__((address_space(1))) Tp* gptr_t;
  return (Tp*)(gptr_t)(((unsigned long long)hi << 32) | lo);
}
DI Params ld_params() {
  const volatile __attribute__((address_space(4))) Params* kp = (const volatile __attribute__((address_space(4))) Params*)__builtin_amdgcn_kernarg_segment_ptr();
  Params r;
#define LDF(f_) r.f_ = uni(kp->f_)
  LDF(xp); LDF(xs); LDF(meta); LDF(mix_g); LDF(ffn_g); LDF(w_in); LDF(q_a_g); LDF(kv_a_g); LDF(w_uq); LDF(w_ukv); LDF(q_g0); LDF(k_g0);
  LDF(conv_w); LDF(w_out0); LDF(w_qkv); LDF(q_g1); LDF(k_g1); LDF(w_out1); LDF(w1); LDF(w3); LDF(w2); LDF(out); LDF(ws); LDF(hmeta);
#undef LDF
  return r;
}
constexpr size_t O_W = OFF_W, O_SS = 46 * MiB, O_R1 = OFF_R1, O_R2 = OFF_R2, O_R3 = OFF_R3, O_HBA = 800 * MiB;
constexpr size_t O_Z = O_R2, O_QPRE = O_R2, O_KNPRE = O_R2 + 145 * MiB, O_CQN = O_R3, O_CKVN = O_R3 + 73 * MiB, O_VT0 = O_R3 + 122 * MiB,
                 O_KR = O_R3 + 220 * MiB, O_ACT = O_R2, O_QKPRE = O_R2, O_VT1 = O_R3, O_Q1 = O_R3 + 49 * MiB, O_K1 = O_R3 + 242 * MiB;
constexpr size_t O_K0_IN_OUT = 145 * MiB;
#define WSP(P_, off_) ((u16*)((P_).ws + (off_)))
#define WW(P_, woff_) (WSP(P_, O_W) + (woff_))

__global__ void __launch_bounds__(NTHREADS) fwd_megakernel(Params Punused) {
  extern __shared__ __attribute__((aligned(16))) char smem[];
  cg::grid_group grid = cg::this_grid();
  const int wv = __builtin_amdgcn_readfirstlane((int)(threadIdx.x >> 6));
  volatile LAS3 unsigned* xst = (volatile LAS3 unsigned*)(smem + pg8::STAGE_BYTES);
  if (threadIdx.x < 4) xst[threadIdx.x] = 0u;
  __syncthreads();
  { const Params P = ld_params(); (void)xcd_barrier_post((unsigned*)(P.ws + O_BAR), xst); }
#define GRID_BAR() do { const Params Pb_ = ld_params(); xcd_barrier((unsigned*)(Pb_.ws + O_BAR), xb_xcc_id(), xst); } while (0)
  {
    const Params P = ld_params();
    u16* W = WSP(P, O_W);
    transpose_job(P.w_in, W + W_IN, 1024, IN0, 4, nullptr, wv);
    transpose_job(P.w_uq, W + W_UQ, 384, 768, 0, nullptr, wv);
    transpose_job(P.w_ukv, W + W_UKV, 256, 1024, 0, nullptr, wv);
    transpose_job(P.w_out0, W + W_OUT0, 1024, 1024, 0, nullptr, wv);
    transpose_job(P.w_qkv, W + W_QKV, 1024, 1536, 0, P.mix_g + DM, wv);
    transpose_job(P.w_out1, W + W_OUT1, 1024, 1024, 0, nullptr, wv);
    for (int l = 0; l < 2; ++l) {
      transpose_job(P.w1 + (size_t)l * 1024 * FFN, W + W_13 + (size_t)l * 5632 * 1024, 1024, FFN, 1, P.ffn_g + l * DM, wv);
      transpose_job(P.w3 + (size_t)l * 1024 * FFN, W + W_13 + (size_t)l * 5632 * 1024, 1024, FFN, 2, P.ffn_g + l * DM, wv);
      transpose_job(P.w2 + (size_t)l * 1024 * FFN, W + W_2 + (size_t)l * 1024 * FFN, FFN, 1024, 0, nullptr, wv);
    }
    norm_phase<true>(P, P.mix_g, WSP(P, O_R1), wv);
    float* ssq = (float*)(P.ws + O_SS);
    for (int i = obid() * NTHREADS + otid(wv); i < 3 * T; i += gridDim.x * NTHREADS) ssq[i] = 0.f;
  }
  grid.sync();
  { const Params P = ld_params();
    run_gemm(smem, WSP(P, O_R1), WW(P, W_IN), 2304, 1024, EpiZ{WSP(P, O_Z)}, 0, wv); }
  GRID_BAR();
  { const Params P = ld_params();
    e1_phase(P, WSP(P, O_Z), WSP(P, O_CQN), WSP(P, O_CKVN), WSP(P, O_KR), WSP(P, O_R1), wv); }
  GRID_BAR();
  { const Params P = ld_params();
    run_gemm(smem, WSP(P, O_CQN), WW(P, W_UQ), 768, 384, EpiStore{WSP(P, O_QPRE), 768, 768}, 0, wv); }
  { const Params P = ld_params();
    run_gemm(smem, WSP(P, O_CKVN), WW(P, W_UKV), 1024, 256, EpiKV0{WSP(P, O_KNPRE), WSP(P, O_VT0)}, (int)gridDim.x - (3 * (TP / 256)) % (int)gridDim.x, wv); }
  GRID_BAR();
  { const Params P = ld_params();
    e2_phase(P, WSP(P, O_QPRE), WSP(P, O_KNPRE), WSP(P, O_KR), (u16*)P.out, (u16*)((char*)P.out + O_K0_IN_OUT), wv);
    zero_vt_pad(WSP(P, O_VT0), NSEQ * 4 * 128, wv); }
  GRID_BAR();
  { const Params P = ld_params();
    attn_phase<192, 4, 4, true>((const u16*)P.out, (const u16*)((char*)P.out + O_K0_IN_OUT), WSP(P, O_VT0), WSP(P, O_R1), P.q_g0, P.k_g0, smem, wv); }
  GRID_BAR();
  { const Params P = ld_params();
    run_gemm(smem, WSP(P, O_R1), WW(P, W_OUT0), 1024, 1024, EpiRes<0>{P, nullptr, WSP(P, O_HBA), (float*)(P.ws + O_SS)}, 0, wv); }
  GRID_BAR();
  { const Params P = ld_params();
    run_gemm(smem, WSP(P, O_HBA), WW(P, W_13), 5632, 1024, EpiSwiglu{WSP(P, O_ACT), (const float*)(P.ws + O_SS)}, 0, wv); }
  GRID_BAR();
  { const Params P = ld_params();
    run_gemm(smem, WSP(P, O_ACT), WW(P, W_2), 1024, FFN, EpiRes<1>{P, WSP(P, O_HBA), WSP(P, O_R1), (float*)(P.ws + O_SS) + T}, 0, wv); }
  GRID_BAR();
  { const Params P = ld_params();
    run_gemm(smem, WSP(P, O_R1), WW(P, W_QKV), 1536, 1024, EpiQKV1{WSP(P, O_QKPRE), WSP(P, O_VT1), (const float*)(P.ws + O_SS) + T}, 0, wv); }
  GRID_BAR();
  { const Params P = ld_params();
    e3_phase(P, WSP(P, O_QKPRE), WSP(P, O_K1), wv);
    zero_vt_pad(WSP(P, O_VT1), NSEQ * 2 * 128, wv); }
  GRID_BAR();
  { const Params P = ld_params();
    attn_phase_l1<8, 2>(WSP(P, O_QKPRE), WSP(P, O_K1), WSP(P, O_VT1), (u16*)P.out, P.q_g1, smem, wv); }
  GRID_BAR();
  { const Params P = ld_params();
    run_gemm(smem, (const u16*)P.out, WW(P, W_OUT1), 1024, 1024, EpiRes<3>{P, WSP(P, O_R1), WSP(P, O_HBA), (float*)(P.ws + O_SS) + 2 * T}, 0, wv, TQ); }
  GRID_BAR();
  { const Params P = ld_params();
    run_gemm(smem, WSP(P, O_HBA), WW(P, W_13 + (size_t)5632 * 1024), 5632, 1024, EpiSwiglu{WSP(P, O_ACT), (const float*)(P.ws + O_SS) + 2 * T}, 0, wv, TQ); }
  GRID_BAR();
  { const Params P = ld_params();
    run_gemm(smem, WSP(P, O_ACT), WW(P, W_2 + (size_t)1024 * FFN), 1024, FFN, EpiRes<4>{P, WSP(P, O_HBA), nullptr, nullptr}, 0, wv, TQ); }
}

extern "C" void kernel_launch(void* const* d_in, const int* in_sizes, int n_in, void* d_out, int out_size, void* d_ws, size_t ws_size,
                              hipStream_t stream) {
  static int grid_blocks = 0;
  if (!grid_blocks) {
    if (hipFuncSetAttribute((const void*)fwd_megakernel, hipFuncAttributeMaxDynamicSharedMemorySize, SMEM_BYTES) != hipSuccess)
      fprintf(stderr, "kernel_launch: hipFuncSetAttribute failed\n");
    int dev = 0, cus = 0, per_cu = 0;
    hipGetDevice(&dev);
    hipDeviceGetAttribute(&cus, hipDeviceAttributeMultiprocessorCount, dev);
    if (hipOccupancyMaxActiveBlocksPerMultiprocessor(&per_cu, (const void*)fwd_megakernel, NTHREADS, SMEM_BYTES) != hipSuccess || per_cu < 1) per_cu = 1;
    (void)hipGetLastError();
    grid_blocks = cus * per_cu;
  }
  Params p;
  memset(&p, 0, sizeof(p));
  p.xp = (const float*)d_in[0]; p.xs = (const float*)d_in[1]; p.meta = (const float*)d_in[2]; p.mix_g = (const float*)d_in[3];
  p.ffn_g = (const float*)d_in[4]; p.w_in = (const float*)d_in[5]; p.q_a_g = (const float*)d_in[6]; p.kv_a_g = (const float*)d_in[7];
  p.w_uq = (const float*)d_in[8]; p.w_ukv = (const float*)d_in[9]; p.q_g0 = (const float*)d_in[10]; p.k_g0 = (const float*)d_in[11];
  p.conv_w = (const float*)d_in[12]; p.w_out0 = (const float*)d_in[13]; p.w_qkv = (const float*)d_in[14]; p.q_g1 = (const float*)d_in[15];
  p.k_g1 = (const float*)d_in[16]; p.w_out1 = (const float*)d_in[17]; p.w1 = (const float*)d_in[18]; p.w3 = (const float*)d_in[19];
  p.w2 = (const float*)d_in[20];
  p.out = (float*)d_out; p.ws = (char*)d_ws; p.hmeta = (float*)((char*)d_ws + OFF_HM);
  (void)hipMemsetAsync((char*)d_ws + O_BAR, 0, XCD_BAR_WORDS * sizeof(unsigned), stream);
  void* args[] = {&p};
  hipError_t e = hipLaunchCooperativeKernel((const void*)fwd_megakernel, dim3(grid_blocks), dim3(NTHREADS), args, SMEM_BYTES, stream);
  if (e != hipSuccess) fprintf(stderr, "cooperative launch failed: %s (grid %d)\n", hipGetErrorString(e), grid_blocks);
}
```

```cpp
#include <hip/hip_runtime.h>
#include <hip/hip_cooperative_groups.h>
#include <cstdio>
#include <cstring>
namespace cg = cooperative_groups;

#define DI __device__ __forceinline__
typedef unsigned short u16;
using bf16x8   = __attribute__((ext_vector_type(8))) short;
using f32x16   = __attribute__((ext_vector_type(16))) float;
using f32x4    = __attribute__((ext_vector_type(4))) float;
using f32x2    = __attribute__((ext_vector_type(2))) float;
using u32x4    = __attribute__((ext_vector_type(4))) unsigned;
using u32x2    = __attribute__((ext_vector_type(2))) unsigned;
using bf16x2_t = __attribute__((ext_vector_type(2))) __bf16;

constexpr int NTHREADS = 512;
constexpr int DM = 1024, NSEQ = 24, NMETA = 16, SEQ = 4096, L = SEQ + NMETA, LP = 4160, T = NSEQ * L;
constexpr int IN0 = 2240, FFN = 2816;
constexpr float EPS = 1e-6f;

constexpr size_t MiB = 1024 * 1024;
constexpr size_t OFF_W = 0, OFF_HM = 48 * MiB, OFF_R1 = 50 * MiB, OFF_R2 = 243 * MiB, OFF_R3 = 665 * MiB;
constexpr size_t W_IN = 0, W_UQ = W_IN + (size_t)2304 * 1024, W_UKV = W_UQ + 768 * 384, W_OUT0 = W_UKV + 1024 * 256,
                 W_QKV = W_OUT0 + 1024 * 1024, W_OUT1 = W_QKV + 1536 * 1024, W_13 = W_OUT1 + 1024 * 1024,
                 W_2 = W_13 + 2 * (size_t)5632 * 1024, W_END = W_2 + 2 * (size_t)1024 * FFN;
static_assert(W_END * 2 <= 48 * MiB, "weights region");

struct Params {
  const float *xp, *xs, *meta, *mix_g, *ffn_g, *w_in, *q_a_g, *kv_a_g, *w_uq, *w_ukv, *q_g0, *k_g0, *conv_w, *w_out0,
      *w_qkv, *q_g1, *k_g1, *w_out1, *w1, *w3, *w2;
  float* out;
  char* ws;
  float* hmeta;
};

DI unsigned cvtpk(float lo, float hi) { f32x2 v = {lo, hi}; return __builtin_bit_cast(unsigned, __builtin_convertvector(v, bf16x2_t)); }
DI float bf_lo(unsigned u) { return __uint_as_float(u << 16); }
DI float bf_hi(unsigned u) { return __uint_as_float(u & 0xffff0000u); }
DI u16 f2bf(float x) { return (u16)(cvtpk(x, 0.f) & 0xffffu); }
DI int obid() { int b = blockIdx.x; asm volatile("" : "+s"(b)); return b; }
DI int otid(int wv) { int t; asm volatile("v_mbcnt_lo_u32_b32 %0, -1, 0\n\tv_mbcnt_hi_u32_b32 %0, -1, %0\n\tv_lshl_or_b32 %0, %1, 6, %0" : "=&v"(t) : "s"(wv)); return t; }
DI float wave_sum(float v) {
#pragma unroll
  for (int o = 32; o; o >>= 1) v += __shfl_xor(v, o);
  return v;
}
DI float sum16(float v) {
#pragma unroll
  for (int o = 8; o; o >>= 1) v += __shfl_xor(v, o);
  return v;
}
DI void unpack8(u32x4 v, float* f) {
#pragma unroll
  for (int i = 0; i < 4; ++i) { f[2 * i] = bf_lo(v[i]); f[2 * i + 1] = bf_hi(v[i]); }
}
DI u32x4 pack8(const float* f) { return u32x4{cvtpk(f[0], f[1]), cvtpk(f[2], f[3]), cvtpk(f[4], f[5]), cvtpk(f[6], f[7])}; }

DI const float* xrow(const Params& P, int t) {
  int s = t / L, p = t - s * L;
  if (p < NMETA) return P.meta + p * DM;
  const float* base = s < 8 ? P.xp + (size_t)(s * SEQ) * DM : P.xs + (size_t)((s - 8) * SEQ) * DM;
  return base + (size_t)(p - NMETA) * DM;
}
DI float* hrow(const Params& P, int t) {
  int s = t / L, p = t - s * L;
  if (p < NMETA) return P.hmeta + (s * NMETA + p) * DM;
  return P.out + ((size_t)s * SEQ + (p - NMETA)) * DM;
}

DI void transpose_job(const float* __restrict__ src, u16* __restrict__ dst, int K, int N, int mode, const float* __restrict__ gain, const int wv) {
  const int tid = otid(wv), lane = tid & 63, wave = tid >> 6;
  const int nkb = K / 32, nnb = N / 64;
  for (int ti = obid() * 8 + wave; ti < nkb * nnb; ti += gridDim.x * 8) {
    const int kb = ti / nnb, nb = ti - kb * nnb;
    const float* sp = src + (size_t)(kb * 32) * N + nb * 64 + lane;
    float v[32];
#pragma unroll
    for (int kk = 0; kk < 32; ++kk) v[kk] = sp[(size_t)kk * N];
    if (gain) {
#pragma unroll
      for (int kk = 0; kk < 32; ++kk) v[kk] *= gain[kb * 32 + kk];
    }
    const int n = nb * 64 + lane;
    int drow;
    if (mode == 4) {
      if (n < 1216) drow = n;
      else { const int c = (n - 1216) & 511, isu = (n >= 1728); drow = 1280 + (c >> 7) * 256 + isu * 128 + (c & 127); }
    } else drow = mode ? (n >> 7) * 256 + (mode - 1) * 128 + (n & 127) : n;
    u16* dp = dst + (size_t)drow * K + kb * 32;
#pragma unroll
    for (int q = 0; q < 4; ++q) *(u32x4*)(dp + q * 8) = pack8(&v[q * 8]);
  }
}

template <bool FROMX>
DI void norm_phase(const Params& P, const float* __restrict__ g, u16* __restrict__ hn, const int wv) {
  const int tid_ = otid(wv), wave = tid_ >> 6, lane = tid_ & 63;
  for (int t = obid() * 8 + wave; t < T; t += gridDim.x * 8) {
    const float* r = xrow(P, t);
    f32x4 v[4];
    float ss = 0.f;
#pragma unroll
    for (int j = 0; j < 4; ++j) {
      v[j] = *(const f32x4*)(r + j * 256 + lane * 4);
      ss += v[j][0] * v[j][0] + v[j][1] * v[j][1] + v[j][2] * v[j][2] + v[j][3] * v[j][3];
    }
    ss = wave_sum(ss);
    const float rs = rsqrtf(ss * (1.f / DM) + EPS);
#pragma unroll
    for (int j = 0; j < 4; ++j) {
      const f32x4 gg = *(const f32x4*)(g + j * 256 + lane * 4);
      u32x2 o = {cvtpk(v[j][0] * rs * gg[0], v[j][1] * rs * gg[1]), cvtpk(v[j][2] * rs * gg[2], v[j][3] * rs * gg[3])};
      *(u32x2*)(hn + (size_t)t * DM + j * 256 + lane * 4) = o;
    }
  }
}

namespace pg8 {
#define PG8_LAS __attribute__((address_space(3)))
constexpr int BM = 256, BKK = 64, HALF = 128, HTB = HALF * BKK * 2, STAGE_BYTES = 8 * HTB, NXCD = 8, WGM = 8;
DI int lds_byte(int r, int c) { const int st = (r >> 4) * 2 + (c >> 5), rr = r & 15, cc = c & 31, ob = rr * 64 + cc * 2; return st * 1024 + (ob ^ (((ob >> 9) & 1) << 5)); }
DI void stage_rc(int b, int& R, int& C) { const int st = b / 1024, sb = b % 1024, swz = sb ^ (((sb >> 9) & 1) << 5); R = (st >> 1) * 16 + swz / 64; C = (st & 1) * 32 + (swz % 64) / 2; }
DI int perm32(int rho) { const int n = rho >> 4, i = rho & 15; return 8 * (i >> 2) + 4 * n + (i & 3); }
struct Unit { int pm, pn; };
struct Gemm { const u16* A; const u16* Bt; int M, N, K; };
struct StaticOrder {
  int nM, nN, nwg, G, c;
  DI void init(int M, int N, int G_, int c_) { nM = M / BM; nN = N / BM; nwg = nM * nN; G = G_; c = c_; }
  DI bool next(int i, Unit& u) const {
    const long Lx = (long)i * G + c; if (__builtin_amdgcn_readfirstlane((int)(Lx >= nwg))) return false;
    int wgid = (int)Lx; { const int q = nwg / NXCD, r = nwg % NXCD, xcd = wgid % NXCD, off = wgid / NXCD; wgid = (xcd < r ? xcd * (q + 1) : r * (q + 1) + (xcd - r) * q) + off; }
    const int nig = WGM * nN, gid = wgid / nig, fm = gid * WGM, gsz = (nM - fm) < WGM ? (nM - fm) : WGM;
    u.pm = __builtin_amdgcn_readfirstlane(fm + ((wgid % nig) % gsz)); u.pn = __builtin_amdgcn_readfirstlane((wgid % nig) / gsz); return true;
  }
};
template <class Epi>
DI void gemm_phase(PG8_LAS unsigned char* lds, const Gemm g, const StaticOrder& S, const Epi& E, const int wv) {
  const int tid = otid(wv), wid = __builtin_amdgcn_readfirstlane(tid >> 6), lane = tid & 63, wr = wid >> 2, wc = wid & 3, fr = lane & 15, fq = lane >> 4;
  const int K = g.K, nt = K / BKK;
  unsigned voffA[2], voffB[2];
#pragma unroll
  for (int i = 0; i < 2; ++i) { int R, C; stage_rc(tid * 16 + i * 8192, R, C); const int Rb = (R & ~31) + perm32(R & 31);
    voffA[i] = (unsigned)(R * K + C) * 2u; voffB[i] = (unsigned)(Rb * K + C) * 2u; }
  const size_t kstep = (size_t)(BKK * 2);
  const size_t hstep = (size_t)HALF * K * 2;
  const size_t tstep = 2 * hstep;
  const unsigned ldsw = (unsigned)wid * 1024u;
  const int aoff = lds_byte(wr * 64 + fr, fq * 8), boff = lds_byte(wc * 32 + fr, fq * 8);
#define PG8_SA(b, h) (((b) * 2 + (h)) * HTB)
#define PG8_SB(b, h) ((4 + (b) * 2 + (h)) * HTB)
#define PG8_STAGE(bufoff, gbase, voff) do { _Pragma("unroll") for (int _i = 0; _i < 2; ++_i) \
    __builtin_amdgcn_global_load_lds((const unsigned*)((const char*)(gbase) + (voff)[_i]), (PG8_LAS unsigned*)(lds + (bufoff) + ldsw + _i * 8192), 16, 0, 0); } while (0)
#define PG8_LDA(dst, b, h) do { _Pragma("unroll") for (int m = 0; m < 4; ++m) _Pragma("unroll") for (int k = 0; k < 2; ++k) dst[m][k] = *(const PG8_LAS bf16x8*)(lds + PG8_SA(b, h) + aoff + m * 2048 + k * 1024); } while (0)
#define PG8_LDB(dst, b, h) do { _Pragma("unroll") for (int n = 0; n < 2; ++n) _Pragma("unroll") for (int k = 0; k < 2; ++k) dst[n][k] = *(const PG8_LAS bf16x8*)(lds + PG8_SB(b, h) + boff + n * 2048 + k * 1024); } while (0)
#define PG8_MMA(ai, bj, At, Bt) do { __builtin_amdgcn_s_setprio(1); _Pragma("unroll") for (int m = 0; m < 4; ++m) _Pragma("unroll") for (int n = 0; n < 2; ++n) _Pragma("unroll") for (int k = 0; k < 2; ++k) \
    acc[ai][bj][m][n] = __builtin_amdgcn_mfma_f32_16x16x32_bf16(Bt[n][k], At[m][k], acc[ai][bj][m][n], 0, 0, 0); __builtin_amdgcn_s_setprio(0); } while (0)
#define PG8_WAIT_V(n) asm volatile("s_waitcnt vmcnt(" #n ")" ::: "memory")
#define PG8_WAIT_L(n) asm volatile("s_waitcnt lgkmcnt(" #n ")" ::: "memory")
#define PG8_BAR __builtin_amdgcn_s_barrier()
#define PG8_SCHED __builtin_amdgcn_sched_barrier(0)
  Unit cur, nxt; int ui = 0;
  if (!S.next(0, cur)) return;
  f32x4 acc[2][2][4][2];
#pragma unroll
  for (int a = 0; a < 2; ++a)
#pragma unroll
    for (int b = 0; b < 2; ++b)
#pragma unroll
      for (int m = 0; m < 4; ++m)
#pragma unroll
        for (int n = 0; n < 2; ++n) acc[a][b][m][n] = (f32x4){0.f, 0.f, 0.f, 0.f};
  bf16x8 At[4][2], B0[2][2], B1[2][2];
  const char* cA = (const char*)g.A + (size_t)cur.pm * tstep; const char* cB = (const char*)g.Bt + (size_t)cur.pn * tstep;
  PG8_STAGE(PG8_SB(0, 0), cB, voffB); PG8_STAGE(PG8_SA(0, 0), cA, voffA); PG8_STAGE(PG8_SB(0, 1), cB + hstep, voffB); PG8_STAGE(PG8_SA(0, 1), cA + hstep, voffA);
  if (wr == 1) PG8_BAR;
  PG8_WAIT_V(4); PG8_BAR;
  PG8_STAGE(PG8_SB(1, 0), cB + kstep, voffB); PG8_STAGE(PG8_SA(1, 0), cA + kstep, voffA); PG8_STAGE(PG8_SB(1, 1), cB + hstep + kstep, voffB);
  PG8_WAIT_V(6); PG8_BAR;
  for (;;) {
    const bool has_next = S.next(ui + 1, nxt);
    const char* nA = has_next ? (const char*)g.A + (size_t)nxt.pm * tstep : cA; const char* nB = has_next ? (const char*)g.Bt + (size_t)nxt.pn * tstep : cB;
#pragma nounroll
    for (int t = 0; t < nt; t += 2) {
      const bool last = (t == nt - 2);
      const char* a1 = cA + (size_t)(t + 1) * kstep;
      const char* a2 = last ? nA : cA + (size_t)(t + 2) * kstep; const char* b2 = last ? nB : cB + (size_t)(t + 2) * kstep;
      const char* a3 = a2 + kstep; const char* b3 = b2 + kstep;
      PG8_LDB(B0, 0, 0); PG8_SCHED; PG8_LDA(At, 0, 0); PG8_STAGE(PG8_SA(1, 1), a1 + hstep, voffA);
      PG8_WAIT_L(8); PG8_BAR; PG8_WAIT_L(0); PG8_MMA(0, 0, At, B0); PG8_BAR; PG8_SCHED;
      PG8_LDB(B1, 0, 1); PG8_STAGE(PG8_SB(0, 0), b2, voffB);
      PG8_BAR; PG8_WAIT_L(0); PG8_MMA(0, 1, At, B1); PG8_BAR;
      PG8_LDA(At, 0, 1); PG8_STAGE(PG8_SA(0, 0), a2, voffA);
      PG8_BAR; PG8_WAIT_L(0); PG8_MMA(1, 0, At, B0); PG8_BAR; PG8_SCHED;
      PG8_STAGE(PG8_SB(0, 1), b2 + hstep, voffB);
      PG8_WAIT_V(6); PG8_BAR; PG8_MMA(1, 1, At, B1); PG8_BAR;
      PG8_LDB(B0, 1, 0); PG8_SCHED; PG8_LDA(At, 1, 0); PG8_STAGE(PG8_SA(0, 1), a2 + hstep, voffA);
      PG8_WAIT_L(8); PG8_BAR; PG8_WAIT_L(0); PG8_MMA(0, 0, At, B0); PG8_BAR; PG8_SCHED;
      PG8_LDB(B1, 1, 1); PG8_STAGE(PG8_SB(1, 0), b3, voffB);
      PG8_BAR; PG8_WAIT_L(0); PG8_MMA(0, 1, At, B1); PG8_BAR;
      PG8_LDA(At, 1, 1); PG8_STAGE(PG8_SA(1, 0), a3, voffA);
      PG8_BAR; PG8_WAIT_L(0); PG8_MMA(1, 0, At, B0); PG8_BAR; PG8_SCHED;
      PG8_STAGE(PG8_SB(1, 1), b3 + hstep, voffB);
      PG8_WAIT_V(6); PG8_BAR; PG8_MMA(1, 1, At, B1); PG8_BAR;
    }
    E(acc, cur, wr, wc, fr, fq);
    if (!has_next) break;
#pragma unroll
    for (int a = 0; a < 2; ++a)
#pragma unroll
      for (int b = 0; b < 2; ++b)
#pragma unroll
        for (int m = 0; m < 4; ++m)
#pragma unroll
          for (int n = 0; n < 2; ++n) acc[a][b][m][n] = (f32x4){0.f, 0.f, 0.f, 0.f};
    cur = nxt; cA = nA; cB = nB; ++ui;
  }
  PG8_WAIT_V(0);
  if (wr == 0) PG8_BAR;
  PG8_BAR;
#undef PG8_SA
#undef PG8_SB
#undef PG8_STAGE
#undef PG8_LDA
#undef PG8_LDB
#undef PG8_MMA
#undef PG8_WAIT_V
#undef PG8_WAIT_L
#undef PG8_BAR
#undef PG8_SCHED
}
}

constexpr int TQ = NSEQ * SEQ;
constexpr int TP = 98816;
constexpr int SMEM_BYTES = pg8::STAGE_BYTES + 16;
typedef const f32x4 (&AccRef)[2][2][4][2];
DI u32x4 pack8v(f32x4 a, f32x4 b) { return u32x4{cvtpk(a[0], a[1]), cvtpk(a[2], a[3]), cvtpk(b[0], b[1]), cvtpk(b[2], b[3])}; }

DI int vt_pos(int p) { return (p & ~12) | ((p & 4) << 1) | ((p & 8) >> 1); }
#define EPI_ROWS_BEGIN() \
  _Pragma("unroll") for (int ai = 0; ai < 2; ++ai) { if (u.pm * 256 + ai * 128 >= T) continue;
#define EPI_ROWS_END() }

struct EpiStore {
  u16* out; int ldc; int nvalid;
  DI void operator()(AccRef acc, const pg8::Unit& u, int wr, int wc, int fr, int fq) const {
    const int row0 = u.pm * 256 + wr * 64 + fr, col0 = u.pn * 256 + wc * 32 + 8 * fq;
    EPI_ROWS_BEGIN()
#pragma unroll
      for (int m = 0; m < 4; ++m) {
        u16* rp = out + (size_t)(row0 + ai * 128 + m * 16) * ldc + col0;
#pragma unroll
        for (int bj = 0; bj < 2; ++bj)
          if (col0 + bj * 128 < nvalid) *(u32x4*)(rp + bj * 128) = pack8v(acc[ai][bj][m][0], acc[ai][bj][m][1]);
      }
    EPI_ROWS_END()
  }
};
constexpr int ZLD = 1728;
struct EpiZ {
  u16* z; u16* cq; u16* ckv; u16* kr; float* ssq_; float* sskv_;
  DI void operator()(AccRef acc, const pg8::Unit& u, int wr, int wc, int fr, int fq) const {
    const int row0 = u.pm * 256 + wr * 64 + fr;
    EPI_ROWS_BEGIN()
#pragma unroll
      for (int m = 0; m < 4; ++m) {
        const int row = row0 + ai * 128 + m * 16;
        u16* rp = z + (size_t)row * ZLD;
        if (u.pn < 5) {
          const int col0 = u.pn * 256 + wc * 32 + 8 * fq;
          float s2q = 0.f, s2kv = 0.f;
#pragma unroll
          for (int bj = 0; bj < 2; ++bj) {
            const int col = col0 + bj * 128;
            if (col < 1216) {
              const f32x4 v0 = acc[ai][bj][m][0], v1 = acc[ai][bj][m][1];
              const u32x4 w = pack8v(v0, v1);
              const float s2 = v0[0] * v0[0] + v0[1] * v0[1] + v0[2] * v0[2] + v0[3] * v0[3] + v1[0] * v1[0] + v1[1] * v1[1] + v1[2] * v1[2] + v1[3] * v1[3];
              if (col < 384)      { *(u32x4*)(cq + (size_t)row * 384 + col) = w; s2q += s2; }
              else if (col < 640) { *(u32x4*)(ckv + (size_t)row * 256 + (col - 384)) = w; s2kv += s2; }
              else if (col < 704) { *(u32x4*)(kr + (size_t)row * 64 + (col - 640)) = w; }
              else                { *(u32x4*)(rp + col) = w; }
            }
          }
          if (u.pn <= 2) {
            s2q += __shfl_xor(s2q, 16); s2q += __shfl_xor(s2q, 32);
            s2kv += __shfl_xor(s2kv, 16); s2kv += __shfl_xor(s2kv, 32);
            if (fq == 0 && u.pn <= 1) atomicAdd(ssq_ + row, s2q);
            if (fq == 0 && u.pn >= 1) atomicAdd(sskv_ + row, s2kv);
          }
        } else {
          const int col0 = 1216 + (u.pn - 5) * 128 + wc * 32 + 8 * fq;
          *(u32x4*)(rp + col0) = pack8v(acc[ai][0][m][0] * acc[ai][1][m][0], acc[ai][0][m][1] * acc[ai][1][m][1]);
        }
      }
    EPI_ROWS_END()
  }
};
struct EpiStoreRS {
  u16* out; int ldc; const float* ss; float inv_k;
  DI void operator()(AccRef acc, const pg8::Unit& u, int wr, int wc, int fr, int fq) const {
    const int row0 = u.pm * 256 + wr * 64 + fr, col0 = u.pn * 256 + wc * 32 + 8 * fq;
    EPI_ROWS_BEGIN()
      float rs[4];
#pragma unroll
      for (int m = 0; m < 4; ++m) rs[m] = ss[row0 + ai * 128 + m * 16];
#pragma unroll
      for (int m = 0; m < 4; ++m) rs[m] = rsqrtf(rs[m] * inv_k + EPS);
#pragma unroll
      for (int m = 0; m < 4; ++m) {
        u16* rp = out + (size_t)(row0 + ai * 128 + m * 16) * ldc + col0;
#pragma unroll
        for (int bj = 0; bj < 2; ++bj) *(u32x4*)(rp + bj * 128) = pack8v(acc[ai][bj][m][0] * rs[m], acc[ai][bj][m][1] * rs[m]);
      }
    EPI_ROWS_END()
  }
};
struct EpiKV0 {
  u16* kn; u16* vt; const float* ss;
  DI void operator()(AccRef acc, const pg8::Unit& u, int wr, int wc, int fr, int fq) const {
    const int row0 = u.pm * 256 + wr * 64 + fr, w0 = wc * 32 + 8 * fq, head = u.pn;
    EPI_ROWS_BEGIN()
      float rs[4];
#pragma unroll
      for (int m = 0; m < 4; ++m) rs[m] = ss[row0 + ai * 128 + m * 16];
#pragma unroll
      for (int m = 0; m < 4; ++m) rs[m] = rsqrtf(rs[m] * (1.f / 256.f) + EPS);
#pragma unroll
      for (int m = 0; m < 4; ++m) {
        const int row = row0 + ai * 128 + m * 16;
        const int s = row / L, p = row - s * L;
        *(u32x4*)(kn + (size_t)row * 512 + head * 128 + w0) = pack8v(acc[ai][0][m][0] * rs[m], acc[ai][0][m][1] * rs[m]);
        u16* vp = vt + (size_t)((s * 4 + head) * 128 + w0) * LP + vt_pos(p);
#pragma unroll
        for (int n = 0; n < 2; ++n)
#pragma unroll
          for (int e = 0; e < 4; ++e) vp[(size_t)(4 * n + e) * LP] = f2bf(acc[ai][1][m][n][e] * rs[m]);
        asm volatile("" ::: "memory");
      }
    EPI_ROWS_END()
  }
};
struct EpiQKV1 {
  u16* qk; u16* vt; const float* ss;
  DI void operator()(AccRef acc, const pg8::Unit& u, int wr, int wc, int fr, int fq) const {
    const int row0 = u.pm * 256 + wr * 64 + fr, w0 = wc * 32 + 8 * fq;
    EPI_ROWS_BEGIN()
      float rs[4];
#pragma unroll
      for (int m = 0; m < 4; ++m) rs[m] = ss[row0 + ai * 128 + m * 16];
#pragma unroll
      for (int m = 0; m < 4; ++m) rs[m] = rsqrtf(rs[m] * (1.f / DM) + EPS);
#pragma unroll
      for (int m = 0; m < 4; ++m) {
        const int row = row0 + ai * 128 + m * 16;
        if (u.pn < 5) {
#pragma unroll
          for (int bj = 0; bj < 2; ++bj)
            *(u32x4*)(qk + (size_t)row * 1280 + u.pn * 256 + bj * 128 + w0) = pack8v(acc[ai][bj][m][0] * rs[m], acc[ai][bj][m][1] * rs[m]);
        } else {
          const int s = row / L, p = row - s * L;
#pragma unroll
          for (int bj = 0; bj < 2; ++bj) {
            u16* vp = vt + (size_t)((s * 2 + bj) * 128 + w0) * LP + vt_pos(p);
#pragma unroll
            for (int n = 0; n < 2; ++n)
#pragma unroll
              for (int e = 0; e < 4; ++e) vp[(size_t)(4 * n + e) * LP] = f2bf(acc[ai][bj][m][n][e] * rs[m]);
          }
          asm volatile("" ::: "memory");
        }
      }
    EPI_ROWS_END()
  }
};
template <int MODE>
struct EpiRes {
  Params P; const u16* hsrc; u16* hdst; float* ss;
  DI void operator()(AccRef acc, const pg8::Unit& u, int wr, int wc, int fr, int fq) const {
    const int row0 = u.pm * 256 + wr * 64 + fr, col0 = u.pn * 256 + wc * 32 + 8 * fq;
    EPI_ROWS_BEGIN()
      f32x4 r[4][2][2];
      if constexpr (MODE == 0) {
#pragma unroll
        for (int m = 0; m < 4; ++m) {
          const float* src = xrow(P, row0 + ai * 128 + m * 16) + col0;
#pragma unroll
          for (int bj = 0; bj < 2; ++bj) { r[m][bj][0] = *(const f32x4*)(src + bj * 128); r[m][bj][1] = *(const f32x4*)(src + bj * 128 + 4); }
        }
      } else {
        u32x4 rb[4][2];
#pragma unroll
        for (int m = 0; m < 4; ++m)
#pragma unroll
          for (int bj = 0; bj < 2; ++bj) {
            const int rr = row0 + ai * 128 + m * 16;
            const int sr = (MODE == 3) ? rr + NMETA * ((rr >> 12) + 1) : rr;
            rb[m][bj] = *(const u32x4*)(hsrc + (size_t)sr * DM + col0 + bj * 128);
          }
#pragma unroll
        for (int m = 0; m < 4; ++m)
#pragma unroll
          for (int bj = 0; bj < 2; ++bj) {
            r[m][bj][0] = f32x4{bf_lo(rb[m][bj][0]), bf_hi(rb[m][bj][0]), bf_lo(rb[m][bj][1]), bf_hi(rb[m][bj][1])};
            r[m][bj][1] = f32x4{bf_lo(rb[m][bj][2]), bf_hi(rb[m][bj][2]), bf_lo(rb[m][bj][3]), bf_hi(rb[m][bj][3])};
          }
      }
#pragma unroll
      for (int m = 0; m < 4; ++m) {
        const int row = row0 + ai * 128 + m * 16;
        if constexpr (MODE == 4) {
          float* dst = P.out + (size_t)row * DM + col0;
#pragma unroll
          for (int bj = 0; bj < 2; ++bj) {
            *(f32x4*)(dst + bj * 128) = r[m][bj][0] + acc[ai][bj][m][0];
            *(f32x4*)(dst + bj * 128 + 4) = r[m][bj][1] + acc[ai][bj][m][1];
          }
        } else if constexpr (MODE == 2) {
          const int s = row / L, p = row - s * L;
          if (p >= NMETA) {
            float* dst = P.out + ((size_t)s * SEQ + (p - NMETA)) * DM + col0;
#pragma unroll
            for (int bj = 0; bj < 2; ++bj) {
              *(f32x4*)(dst + bj * 128) = r[m][bj][0] + acc[ai][bj][m][0];
              *(f32x4*)(dst + bj * 128 + 4) = r[m][bj][1] + acc[ai][bj][m][1];
            }
          }
        } else {
          float s2 = 0.f;
#pragma unroll
          for (int bj = 0; bj < 2; ++bj) {
            const f32x4 r0 = r[m][bj][0] + acc[ai][bj][m][0], r1 = r[m][bj][1] + acc[ai][bj][m][1];
            *(u32x4*)(hdst + (size_t)row * DM + col0 + bj * 128) = pack8v(r0, r1);
            s2 += r0[0] * r0[0] + r0[1] * r0[1] + r0[2] * r0[2] + r0[3] * r0[3] + r1[0] * r1[0] + r1[1] * r1[1] + r1[2] * r1[2] + r1[3] * r1[3];
          }
          s2 += __shfl_xor(s2, 16);
          s2 += __shfl_xor(s2, 32);
          if (fq == 0) atomicAdd(ss + row, s2);
        }
      }
    EPI_ROWS_END()
  }
};
struct EpiSwiglu {
  u16* act; const float* ss;
  DI void operator()(AccRef acc, const pg8::Unit& u, int wr, int wc, int fr, int fq) const {
    const int row0 = u.pm * 256 + wr * 64 + fr, col0 = u.pn * 128 + wc * 32 + 8 * fq;
    EPI_ROWS_BEGIN()
      float rs[4];
#pragma unroll
      for (int m = 0; m < 4; ++m) rs[m] = ss[row0 + ai * 128 + m * 16];
#pragma unroll
      for (int m = 0; m < 4; ++m) rs[m] = rsqrtf(rs[m] * (1.f / DM) + EPS);
#pragma unroll
      for (int m = 0; m < 4; ++m) {
        const int row = row0 + ai * 128 + m * 16;
        const float ne = rs[m] * -1.4426950408889634f, r2 = rs[m] * rs[m];
        f32x4 y[2];
#pragma unroll
        for (int n = 0; n < 2; ++n)
#pragma unroll
          for (int e = 0; e < 4; ++e) {
            const float a = acc[ai][0][m][n][e], b = acc[ai][1][m][n][e];
            y[n][e] = a * b * r2 * __builtin_amdgcn_rcpf(1.f + __builtin_amdgcn_exp2f(a * ne));
          }
        *(u32x4*)(act + (size_t)row * FFN + col0) = pack8v(y[0], y[1]);
      }
    EPI_ROWS_END()
  }
};
template <class Epi>
DI void run_gemm(char* smem, const u16* A, const u16* Bt, int N, int K, const Epi& E, int shift, const int wv, const int M = TP) {
  pg8::Gemm g{A, Bt, M, N, K};
  pg8::StaticOrder S; S.init(M, N, (int)gridDim.x, (int)((obid() + shift) % gridDim.x));
  pg8::gemm_phase<Epi>((PG8_LAS unsigned char*)smem, g, S, E, wv);
}

DI void e1_phase(const Params& P, const u16* __restrict__ z, u16* __restrict__ cqn, u16* __restrict__ ckvn, u16* __restrict__ kr,
                 u16* __restrict__ mix, const int wv) {
  const int tid_ = otid(wv), wave = tid_ >> 6, lane = tid_ & 63;
  for (int t = obid() * 8 + wave; t < T; t += gridDim.x * 8) {
    const u16* zr = z + (size_t)t * ZLD;
    const int s = t / L, p = t - s * L;
    float f[8], o[8];
    {
      const int c0 = lane * 8;
      float gb[8], a[8], cv[8];
      unpack8(*(const u32x4*)(zr + 704 + c0), gb);
      unpack8(*(const u32x4*)(zr + 1216 + c0), a);
#pragma unroll
      for (int e = 0; e < 8; ++e) cv[e] = P.conv_w[512 + c0 + e] * a[e];
      if (p > 0) {
        unpack8(*(const u32x4*)(zr - ZLD + 1216 + c0), a);
#pragma unroll
        for (int e = 0; e < 8; ++e) cv[e] += P.conv_w[c0 + e] * a[e];
      }
      if (p < L - 1) {
        unpack8(*(const u32x4*)(zr + ZLD + 1216 + c0), a);
#pragma unroll
        for (int e = 0; e < 8; ++e) cv[e] += P.conv_w[1024 + c0 + e] * a[e];
      }
#pragma unroll
      for (int e = 0; e < 8; ++e) o[e] = gb[e] * cv[e];
      *(u32x4*)(mix + (size_t)t * DM + 512 + c0) = pack8(o);
    }
  }
}

DI void zero_vt_pad(u16* vt, int rows, const int wv) {
  const u32x4 zz = {0u, 0u, 0u, 0u};
  for (int idx = obid() * NTHREADS + otid(wv); idx < rows * 6; idx += gridDim.x * NTHREADS) {
    const int row = idx / 6, c = idx - row * 6;
    *(u32x4*)(vt + (size_t)row * LP + L + c * 8) = zz;
  }
}

constexpr float LOG2_THETA = 13.287712379549449f;
constexpr float INV_2PI = 0.15915494309189535f;
DI void rope_sc(float pos, int j, float& sn, float& cs) {
  const float fr = exp2f(-(float)j * (LOG2_THETA / 32.f));
  float tr = pos * fr * INV_2PI;
  tr -= floorf(tr);
  sn = __builtin_amdgcn_sinf(tr);
  cs = __builtin_amdgcn_cosf(tr);
}

DI void e2_phase(const Params& P, const u16* __restrict__ qpre, const u16* __restrict__ knpre, const u16* __restrict__ kr,
                 u16* __restrict__ Qo, u16* __restrict__ Ko, const int wv) {
  const int tid_ = otid(wv), wave = tid_ >> 6, lane = tid_ & 63, hd = lane >> 4, i = lane & 15;
  for (int t = obid() * 8 + wave; t < T; t += gridDim.x * 8) {
    const int s = t / L, p = t - s * L;
    float sn[2], cs[2];
    rope_sc((float)p, 2 * i, sn[0], cs[0]); rope_sc((float)p, 2 * i + 1, sn[1], cs[1]);
#pragma unroll
    for (int which = 0; which < 2; ++which) {
      float nf[8], x1[2], x2[2];
      const float* gg = which ? P.k_g0 : P.q_g0;
      if (which == 0) {
        const u16* src = qpre + (size_t)t * 768 + hd * 192;
        unpack8(*(const u32x4*)(src + 8 * i), nf);
        const unsigned a = *(const unsigned*)(src + 128 + 2 * i), b = *(const unsigned*)(src + 160 + 2 * i);
        x1[0] = bf_lo(a); x1[1] = bf_hi(a); x2[0] = bf_lo(b); x2[1] = bf_hi(b);
      } else {
        unpack8(*(const u32x4*)(knpre + (size_t)t * 512 + hd * 128 + 8 * i), nf);
        const unsigned a = *(const unsigned*)(kr + (size_t)t * 64 + 2 * i), b = *(const unsigned*)(kr + (size_t)t * 64 + 32 + 2 * i);
        x1[0] = bf_lo(a); x1[1] = bf_hi(a); x2[0] = bf_lo(b); x2[1] = bf_hi(b);
      }
      float ss = x1[0] * x1[0] + x1[1] * x1[1] + x2[0] * x2[0] + x2[1] * x2[1];
#pragma unroll
      for (int e = 0; e < 8; ++e) ss += nf[e] * nf[e];
      ss = sum16(ss);
      const float r = rsqrtf(ss * (1.f / 192.f) + EPS);
#pragma unroll
      for (int e = 0; e < 8; ++e) nf[e] = nf[e] * r * gg[8 * i + e];
      float o1[2], o2[2];
#pragma unroll
      for (int e = 0; e < 2; ++e) {
        const float a = x1[e] * r * gg[128 + 2 * i + e], b = x2[e] * r * gg[160 + 2 * i + e];
        o1[e] = a * cs[e] - b * sn[e];
        o2[e] = b * cs[e] + a * sn[e];
      }
      if (which == 0) {
        constexpr float CQ = 0.07216878364870322f * 1.4426950408889634f;
#pragma unroll
        for (int e = 0; e < 8; ++e) nf[e] *= CQ;
        o1[0] *= CQ; o1[1] *= CQ; o2[0] *= CQ; o2[1] *= CQ;
      }
      u16* dst = (which ? Ko : Qo) + (size_t)t * 768 + hd * 192;
      *(u32x4*)(dst + 8 * i) = pack8(nf);
      *(unsigned*)(dst + 128 + 2 * i) = cvtpk(o1[0], o1[1]);
      *(unsigned*)(dst + 160 + 2 * i) = cvtpk(o2[0], o2[1]);
    }
  }
}

DI void e3_phase(const Params& P, const u16* __restrict__ qk, u16* __restrict__ Ko, const int wv) {
  const int tid_ = otid(wv), wave = tid_ >> 6, lane = tid_ & 63, i = lane & 15, kh = (lane >> 4) & 1, tsel = lane >> 5;
  for (int tb = (obid() * 8 + wave) * 2; tb < T; tb += gridDim.x * 16) {
    const int t = tb + tsel;
    const int s = t / L, p = t - s * L;
    float snr[2], csr[2], snc[2], csc[2];
    if (p >= NMETA) {
      const float row = (float)((p - NMETA) >> 6), col = (float)((p - NMETA) & 63);
      rope_sc(row, 2 * i, snr[0], csr[0]); rope_sc(row, 2 * i + 1, snr[1], csr[1]);
      rope_sc(col, 2 * i, snc[0], csc[0]); rope_sc(col, 2 * i + 1, snc[1], csc[1]);
    } else {
      snr[0] = snr[1] = snc[0] = snc[1] = 0.f; csr[0] = csr[1] = csc[0] = csc[1] = 1.f;
    }
    const u16* src = qk + (size_t)t * 1280 + 1024 + kh * 128;
    const float* gg = P.k_g1;
    const unsigned ua1 = *(const unsigned*)(src + 2 * i), ua2 = *(const unsigned*)(src + 32 + 2 * i);
    const unsigned ub1 = *(const unsigned*)(src + 64 + 2 * i), ub2 = *(const unsigned*)(src + 96 + 2 * i);
    float a1[2] = {bf_lo(ua1), bf_hi(ua1)}, a2[2] = {bf_lo(ua2), bf_hi(ua2)};
    float b1[2] = {bf_lo(ub1), bf_hi(ub1)}, b2[2] = {bf_lo(ub2), bf_hi(ub2)};
    float ss = a1[0] * a1[0] + a1[1] * a1[1] + a2[0] * a2[0] + a2[1] * a2[1] + b1[0] * b1[0] + b1[1] * b1[1] + b2[0] * b2[0] + b2[1] * b2[1];
    ss = sum16(ss);
    const float r = rsqrtf(ss * (1.f / 128.f) + EPS);
    float oa1[2], oa2[2], ob1[2], ob2[2];
#pragma unroll
    for (int e = 0; e < 2; ++e) {
      const float xa1 = a1[e] * r * gg[2 * i + e], xa2 = a2[e] * r * gg[32 + 2 * i + e];
      const float xb1 = b1[e] * r * gg[64 + 2 * i + e], xb2 = b2[e] * r * gg[96 + 2 * i + e];
      oa1[e] = xa1 * csr[e] - xa2 * snr[e]; oa2[e] = xa2 * csr[e] + xa1 * snr[e];
      ob1[e] = xb1 * csc[e] - xb2 * snc[e]; ob2[e] = xb2 * csc[e] + xb1 * snc[e];
    }
    u16* dst = Ko + (size_t)t * 256 + kh * 128;
    *(unsigned*)(dst + 2 * i) = cvtpk(oa1[0], oa1[1]);
    *(unsigned*)(dst + 32 + 2 * i) = cvtpk(oa2[0], oa2[1]);
    *(unsigned*)(dst + 64 + 2 * i) = cvtpk(ob1[0], ob1[1]);
    *(unsigned*)(dst + 96 + 2 * i) = cvtpk(ob2[0], ob2[1]);
  }
}

#define RAW_BAR() do { asm volatile("s_waitcnt lgkmcnt(0)" ::: "memory"); __builtin_amdgcn_s_barrier(); asm volatile("" ::: "memory"); } while (0)
DI float xhalf_max(float x) {
  auto rr = __builtin_amdgcn_permlane32_swap(__float_as_uint(x), __float_as_uint(x), false, false);
  return fmaxf(__uint_as_float(rr[0]), __uint_as_float(rr[1]));
}
DI float xhalf_sum(float x) {
  auto rr = __builtin_amdgcn_permlane32_swap(__float_as_uint(x), __float_as_uint(x), false, false);
  return __uint_as_float(rr[0]) + __uint_as_float(rr[1]);
}
template <int DQK, int NHQ, int NHKV, bool HAS_META>
DI void attn_phase(const u16* __restrict__ Q, const u16* __restrict__ K, const u16* __restrict__ Vt, u16* __restrict__ O, const float* __restrict__ qg, const float* __restrict__ kg, char* smem, const int wv) {
  constexpr int NS = DQK / 16, CH = DQK / 8, KSTR = DQK * 2 + 16, VSTR = 144;
  constexpr int KBYTES = 64 * KSTR, VBYTES = 128 * VSTR;
  constexpr int NKC = 64 * CH / NTHREADS;
  constexpr int NT = (L + 63) / 64;
  constexpr bool EARLY_FETCH = (DQK == 128);
  constexpr int LDK = NHKV * DQK;
  static_assert(2 * (KBYTES + VBYTES) <= SMEM_BYTES, "attention LDS");
  const int tid = otid(wv), lane = tid & 63, wave = __builtin_amdgcn_readfirstlane(tid >> 6), r32 = lane & 31, hh = lane >> 5, grp = wave >> 2;
  constexpr int NF = NSEQ * NHQ * 16, nItems = NF + (HAS_META ? NSEQ * NHQ : 0);
#define A_DECODE(it_, hq_, sq_, q0_, ql_) do { if ((it_) < NF) { hq_ = ((it_) >> 4) % NHQ; sq_ = (it_) / (16 * NHQ); q0_ = NMETA + 256 * ((it_) & 15); ql_ = L; } \
    else { const int tt_ = (it_) - NF; hq_ = tt_ % NHQ; sq_ = tt_ / NHQ; q0_ = 0; ql_ = NMETA; } } while (0)
  char* kb0 = smem; char* vb0 = smem + 2 * KBYTES;
  const int lkey = tid >> 3, lc8 = tid & 7;
  const unsigned koff = (unsigned)(lkey * LDK * 2 + lc8 * 16);
  const unsigned koffL = (unsigned)(min(lkey, 15) * LDK * 2 + lc8 * 16);
  const unsigned voff = (unsigned)((lkey * LP + lc8 * 8) * 2);
  const unsigned kwoff = (unsigned)(lkey * KSTR + lc8 * 16), vwoff = (unsigned)(lkey * VSTR + lc8 * 16);
  const int G_ = (int)gridDim.x, b_ = obid();
  int item = (G_ % 8 == 0) ? (b_ % 8) * (G_ / 8) + b_ / 8 : b_;
  if (item >= nItems) return;
  u32x4 rk[NKC], rv[2];
#define A_LOADK(Kb_, tile_) do { const char* kp_ = (const char*)(Kb_) + (size_t)(tile_) * (64 * LDK * 2); const unsigned ko_ = ((tile_) == NT - 1) ? koffL : koff; \
    _Pragma("unroll") for (int i_ = 0; i_ < NKC; ++i_) rk[i_] = *(const u32x4*)(kp_ + ko_ + i_ * 128); } while (0)
#define A_LOADV(Vb_, tile_) do { const char* vp_ = (const char*)(Vb_) + (size_t)(tile_) * 128; \
    rv[0] = *(const u32x4*)(vp_ + voff); rv[1] = *(const u32x4*)(vp_ + voff + 64 * LP * 2); } while (0)
#define A_WRITEK(bi_) do { char* b_ = kb0 + (bi_) * KBYTES + kwoff; \
    _Pragma("unroll") for (int i_ = 0; i_ < NKC; ++i_) *(u32x4*)(b_ + i_ * 128) = rk[i_]; } while (0)
#define A_WRITEV(bi_) do { char* b_ = vb0 + (bi_) * VBYTES + vwoff; \
    *(u32x4*)(b_) = rv[0]; *(u32x4*)(b_ + 64 * VSTR) = rv[1]; } while (0)
#define A_FETCH(j_) do { \
        if ((j_) + 3 < NT) A_LOADK(Kb, (j_) + 3); \
        else if ((j_) == NT - 3 && has_next) A_LOADK(nKb, 0); \
        else if ((j_) == NT - 1 && has_next) A_LOADK(nKb, 1); \
        if ((j_) + 2 < NT) A_LOADV(Vb, (j_) + 2); \
        else if ((j_) == NT - 2 && has_next) A_LOADV(nVb, 0); } while (0)
#define A_QK(bi_) do { const char* sk_ = kb0 + (bi_) * KBYTES + r32 * KSTR + hh * 16; \
    _Pragma("unroll") for (int i_ = 0; i_ < 16; ++i_) { s0[i_] = 0.f; s1[i_] = 0.f; } \
    _Pragma("unroll") for (int i_ = 0; i_ < NS; ++i_) { \
      const bf16x8 k0f_ = *(const bf16x8*)(sk_ + i_ * 32); const bf16x8 k1f_ = *(const bf16x8*)(sk_ + 32 * KSTR + i_ * 32); \
      s0 = __builtin_amdgcn_mfma_f32_32x32x16_bf16(k0f_, qf[i_], s0, 0, 0, 0); \
      s1 = __builtin_amdgcn_mfma_f32_32x32x16_bf16(k1f_, qf[i_], s1, 0, 0, 0); } } while (0)
  int hq, sq, q0, qlim;
  A_DECODE(item, hq, sq, q0, qlim);
  const u16* Kb = K + (size_t)(sq * L) * LDK + (hq / (NHQ / NHKV)) * DQK;
  const u16* Vb = Vt + (size_t)((sq * NHKV + hq / (NHQ / NHKV)) * 128) * LP;
  A_LOADK(Kb, 0); A_WRITEK(0); A_LOADK(Kb, 1); A_LOADV(Vb, 0);
  if (grp == 1) { RAW_BAR(); }
  RAW_BAR();
  float l;
  f32x16 o[4], s0, s1;
  bf16x8 qf[NS], pb[4];
  for (;;) {
    const int pq = q0 + wave * 32 + r32;
    const bool valid = pq < qlim;
    const bool active = (item < NF) || (wave == 0);
    {
      const u16* qrow = Q + (size_t)(sq * L + (valid ? pq : qlim - 1)) * (NHQ * DQK) + hq * DQK + hh * 8;
#pragma unroll
      for (int i = 0; i < NS; ++i) qf[i] = *(const bf16x8*)(qrow + 16 * i);
    }
    l = 0.f;
#pragma unroll
    for (int d = 0; d < 4; ++d)
#pragma unroll
      for (int i = 0; i < 16; ++i) o[d][i] = 0.f;
    const int nitem = item + (int)gridDim.x;
    const bool has_next = nitem < nItems;
    int nhq, nsq, nq0, nqlim;
    A_DECODE(nitem, nhq, nsq, nq0, nqlim);
    const u16* nKb = K + (size_t)(nsq * L) * LDK + (nhq / (NHQ / NHKV)) * DQK;
    const u16* nVb = Vt + (size_t)((nsq * NHKV + nhq / (NHQ / NHKV)) * 128) * LP;
    RAW_BAR();
    A_WRITEK(1); A_WRITEV(0);
    __builtin_amdgcn_sched_barrier(0);
    if (active) A_QK(0);
    __builtin_amdgcn_sched_barrier(0);
    A_LOADK(Kb, 2); A_LOADV(Vb, 1);
    RAW_BAR();
    for (int j = 0; j < NT; ++j) {
      __builtin_amdgcn_s_setprio(0);
      if (active) {
        f32x2 ps2 = {0.f, 0.f};
        unsigned w_[16];
#pragma unroll
        for (int i = 0; i < 8; ++i) {
          f32x2 v;
          v[0] = __builtin_amdgcn_exp2f(s0[2 * i]); v[1] = __builtin_amdgcn_exp2f(s0[2 * i + 1]);
          if (j == NT - 1 && i >= 4) v = f32x2{0.f, 0.f};
          ps2 += v;
          w_[i] = cvtpk(v[0], v[1]);
        }
#pragma unroll
        for (int i = 0; i < 8; ++i) {
          f32x2 v;
          v[0] = __builtin_amdgcn_exp2f(s1[2 * i]); v[1] = __builtin_amdgcn_exp2f(s1[2 * i + 1]);
          if (j == NT - 1) v = f32x2{0.f, 0.f};
          ps2 += v;
          w_[8 + i] = cvtpk(v[0], v[1]);
        }
        l += xhalf_sum(ps2[0] + ps2[1]);
        pb[0] = __builtin_bit_cast(bf16x8, u32x4{w_[0], w_[1], w_[2], w_[3]});
        pb[1] = __builtin_bit_cast(bf16x8, u32x4{w_[4], w_[5], w_[6], w_[7]});
        pb[2] = __builtin_bit_cast(bf16x8, u32x4{w_[8], w_[9], w_[10], w_[11]});
        pb[3] = __builtin_bit_cast(bf16x8, u32x4{w_[12], w_[13], w_[14], w_[15]});
      }
      __builtin_amdgcn_s_setprio(2);
      RAW_BAR();
      if (j + 2 < NT) A_WRITEK(j & 1);
      else if (j == NT - 1 && has_next) A_WRITEK(0);
      if (j + 1 < NT) A_WRITEV((j + 1) & 1);
      __builtin_amdgcn_sched_barrier(0);
      if constexpr (EARLY_FETCH) { A_FETCH(j); __builtin_amdgcn_sched_barrier(0); }
        if (active && j == NT - 1) {
        const char* svl = vb0 + (j & 1) * VBYTES + r32 * VSTR + hh * 16;
        bf16x8 vf[4];
#pragma unroll
        for (int d = 0; d < 4; ++d) vf[d] = *(const bf16x8*)(svl + d * 32 * VSTR);
#pragma unroll
        for (int d = 0; d < 4; ++d) o[d] = __builtin_amdgcn_mfma_f32_32x32x16_bf16(vf[d], pb[0], o[d], 0, 0, 0);
      } else if (active)
      {
        constexpr int NQK = 2 * NS, NM = NQK + 16, RING = (DQK == 128) ? 8 : 6;
        const char* sk = kb0 + ((j + 1) & 1) * KBYTES + r32 * KSTR + hh * 16;
        const char* sv = vb0 + (j & 1) * VBYTES + r32 * VSTR + hh * 16;
        bf16x8 ring[RING];
#define A_FRAG(dst_, i_) do { if ((i_) < NQK) { dst_ = *(const bf16x8*)(sk + ((i_) & 1) * (32 * KSTR) + ((i_) >> 1) * 32); } \
          else { dst_ = *(const bf16x8*)(sv + (((i_) - NQK) & 3) * (32 * VSTR) + (((i_) - NQK) >> 2) * 32); } } while (0)
#pragma unroll
        for (int i = 0; i < 16; ++i) { s0[i] = 0.f; s1[i] = 0.f; }
#pragma unroll
        for (int i = 0; i < RING; ++i) A_FRAG(ring[i], i);
#pragma unroll
        for (int i = 0; i < NM; ++i) {
          if (i < NQK) {
            if (i & 1) s1 = __builtin_amdgcn_mfma_f32_32x32x16_bf16(ring[i % RING], qf[i >> 1], s1, 0, 0, 0);
            else       s0 = __builtin_amdgcn_mfma_f32_32x32x16_bf16(ring[i % RING], qf[i >> 1], s0, 0, 0, 0);
          } else {
            o[(i - NQK) & 3] = __builtin_amdgcn_mfma_f32_32x32x16_bf16(ring[i % RING], pb[(i - NQK) >> 2], o[(i - NQK) & 3], 0, 0, 0);
          }
          if (i + RING < NM) A_FRAG(ring[i % RING], i + RING);
          __builtin_amdgcn_sched_barrier(0);
        }
#undef A_FRAG
      }
        __builtin_amdgcn_sched_barrier(0);
      if constexpr (!EARLY_FETCH) A_FETCH(j);
      if (j == NT - 1 && valid) {
        const float inv = 1.f / l;
        u16* orow = O + (size_t)(HAS_META ? sq * L + pq : sq * SEQ + pq - NMETA) * DM + hq * 128 + hh * 4;
#pragma unroll
        for (int d = 0; d < 4; ++d)
#pragma unroll
          for (int q = 0; q < 4; ++q) {
            u32x2 w = {cvtpk(o[d][4 * q] * inv, o[d][4 * q + 1] * inv), cvtpk(o[d][4 * q + 2] * inv, o[d][4 * q + 3] * inv)};
            *(u32x2*)(orow + d * 32 + q * 8) = w;
          }
      }
      RAW_BAR();
    }
    if (!has_next) break;
    item = nitem; hq = nhq; sq = nsq; q0 = nq0; qlim = nqlim; Kb = nKb; Vb = nVb;
  }
  __builtin_amdgcn_s_setprio(0);
  if (grp == 0) RAW_BAR();
  RAW_BAR();
#undef A_LOADK
#undef A_LOADV
#undef A_WRITEK
#undef A_WRITEV
#undef A_QK
#undef A_FETCH
#undef A_DECODE
}

template <int NHQ, int NHKV>
DI void attn_phase_l1(const u16* __restrict__ Q, const u16* __restrict__ K, const u16* __restrict__ Vt, u16* __restrict__ O, const float* __restrict__ qg, char* smem, const int wv) {
  constexpr int DQK = 128, NS = 8, KSTR = DQK * 2 + 16, VSTR = 144;
  constexpr int KBYTES = 64 * KSTR, VBYTES = 128 * VSTR;
  constexpr int NKC = 2;
  constexpr int NT = (L + 63) / 64;
  constexpr int LDK = NHKV * DQK;
  constexpr int NF = NSEQ * NHQ * 16;
  const int tid = otid(wv), lane = tid & 63, wave = __builtin_amdgcn_readfirstlane(tid >> 6), r32 = lane & 31, hh = lane >> 5;
  char* kb0 = smem; char* vb0 = smem + 2 * KBYTES;
  const int lkey = tid >> 3, lc8 = tid & 7;
  const unsigned koff = (unsigned)(lkey * LDK * 2 + lc8 * 16);
  const unsigned koffL = (unsigned)(min(lkey, 15) * LDK * 2 + lc8 * 16);
  const unsigned voff = (unsigned)((lkey * LP + lc8 * 8) * 2);
  const unsigned kwoff = (unsigned)(lkey * KSTR + lc8 * 16), vwoff = (unsigned)(lkey * VSTR + lc8 * 16);
  const int G_ = (int)gridDim.x, b_ = obid();
  u32x4 rk[NKC], rv[2];
#define B_LOADK(Kb_, tile_) do { const char* kp_ = (const char*)(Kb_) + (size_t)(tile_) * (64 * LDK * 2); const unsigned ko_ = ((tile_) == NT - 1) ? koffL : koff; \
    _Pragma("unroll") for (int i_ = 0; i_ < NKC; ++i_) rk[i_] = *(const u32x4*)(kp_ + ko_ + i_ * 128); } while (0)
#define B_LOADV(Vb_, tile_) do { const char* vp_ = (const char*)(Vb_) + (size_t)(tile_) * 128; \
    rv[0] = *(const u32x4*)(vp_ + voff); rv[1] = *(const u32x4*)(vp_ + voff + 64 * LP * 2); } while (0)
#define B_WRITEK(bi_) do { char* b_w = kb0 + (bi_) * KBYTES + kwoff; \
    _Pragma("unroll") for (int i_ = 0; i_ < NKC; ++i_) *(u32x4*)(b_w + i_ * 128) = rk[i_]; } while (0)
#define B_WRITEV(bi_) do { char* b_w = vb0 + (bi_) * VBYTES + vwoff; \
    *(u32x4*)(b_w) = rv[0]; *(u32x4*)(b_w + 64 * VSTR) = rv[1]; } while (0)
  f32x16 o[4], s0, s1;
  bf16x8 qf[NS], pb[4];
  for (int item = (G_ % 8 == 0) ? (b_ % 8) * (G_ / 8) + b_ / 8 : b_; item < NF; item += G_) {
    const int hq = (item >> 4) % NHQ, sq = item / (16 * NHQ), q0 = NMETA + 256 * (item & 15);
    const u16* Kb = K + (size_t)(sq * L) * LDK + (hq / (NHQ / NHKV)) * DQK;
    const u16* Vb = Vt + (size_t)((sq * NHKV + hq / (NHQ / NHKV)) * 128) * LP;
    const int pq = q0 + wave * 32 + r32;
    {
      const u16* qrow = Q + (size_t)(sq * L + pq) * 1280 + hq * DQK + hh * 8;
      int hho = hh; asm volatile("" : "+v"(hho));
      float ssq = 0.f;
#pragma unroll
      for (int i = 0; i < NS; ++i) {
        qf[i] = *(const bf16x8*)(qrow + 16 * i);
        float t8[8]; unpack8(__builtin_bit_cast(u32x4, qf[i]), t8);
#pragma unroll
        for (int e = 0; e < 8; ++e) ssq += t8[e] * t8[e];
      }
      ssq = xhalf_sum(ssq);
      const float rn = rsqrtf(ssq * (1.f / DQK) + EPS) * (0.08838834764831845f * 1.4426950408889634f);
#define A_QSCALE(dst_, i_) do { unpack8(__builtin_bit_cast(u32x4, qf[i_]), dst_); \
        const f32x4 g0_ = *(const f32x4*)(qg + 16 * (i_) + 8 * hh), g1_ = *(const f32x4*)(qg + 16 * (i_) + 8 * hh + 4); \
        _Pragma("unroll") for (int e_ = 0; e_ < 4; ++e_) { dst_[e_] *= rn * g0_[e_]; dst_[4 + e_] *= rn * g1_[e_]; } } while (0)
#define A_QROPE(ia_, ib_, jb_, pos_) do { float xa_[8], xb_[8]; A_QSCALE(xa_, ia_); A_QSCALE(xb_, ib_); \
        _Pragma("unroll") for (int e_ = 0; e_ < 8; ++e_) { float sn_, cs_; rope_sc(pos_, 16 * (jb_) + 8 * hho + e_, sn_, cs_); \
          const float a_ = xa_[e_], b_ = xb_[e_]; xa_[e_] = a_ * cs_ - b_ * sn_; xb_[e_] = b_ * cs_ + a_ * sn_; } \
        qf[ia_] = __builtin_bit_cast(bf16x8, pack8(xa_)); qf[ib_] = __builtin_bit_cast(bf16x8, pack8(xb_)); } while (0)
      const float prow = (float)((pq - NMETA) >> 6), pcol = (float)((pq - NMETA) & 63);
      A_QROPE(0, 2, 0, prow); A_QROPE(1, 3, 1, prow);
      A_QROPE(4, 6, 0, pcol); A_QROPE(5, 7, 1, pcol);
#undef A_QROPE
#undef A_QSCALE
    }
    float l = 0.f;
#pragma unroll
    for (int d = 0; d < 4; ++d)
#pragma unroll
      for (int i = 0; i < 16; ++i) o[d][i] = 0.f;
    __syncthreads();
    B_LOADK(Kb, 0); B_WRITEK(0); B_LOADK(Kb, 1); B_WRITEK(1); B_LOADV(Vb, 0); B_WRITEV(0);
    B_LOADK(Kb, 2); B_LOADV(Vb, 1);
    __syncthreads();
    {
      const char* sk = kb0 + r32 * KSTR + hh * 16;
#pragma unroll
      for (int i = 0; i < 16; ++i) { s0[i] = 0.f; s1[i] = 0.f; }
#pragma unroll
      for (int i = 0; i < NS; ++i) {
        const bf16x8 k0f = *(const bf16x8*)(sk + i * 32), k1f = *(const bf16x8*)(sk + 32 * KSTR + i * 32);
        s0 = __builtin_amdgcn_mfma_f32_32x32x16_bf16(k0f, qf[i], s0, 0, 0, 0);
        s1 = __builtin_amdgcn_mfma_f32_32x32x16_bf16(k1f, qf[i], s1, 0, 0, 0);
      }
      unsigned w_[16]; f32x2 ps2 = {0.f, 0.f};
#pragma unroll
      for (int i = 0; i < 8; ++i) { f32x2 v; v[0] = __builtin_amdgcn_exp2f(s0[2 * i]); v[1] = __builtin_amdgcn_exp2f(s0[2 * i + 1]); ps2 += v; w_[i] = cvtpk(v[0], v[1]); }
#pragma unroll
      for (int i = 0; i < 8; ++i) { f32x2 v; v[0] = __builtin_amdgcn_exp2f(s1[2 * i]); v[1] = __builtin_amdgcn_exp2f(s1[2 * i + 1]); ps2 += v; w_[8 + i] = cvtpk(v[0], v[1]); }
      l += ps2[0] + ps2[1];
#pragma unroll
      for (int q = 0; q < 4; ++q) pb[q] = __builtin_bit_cast(bf16x8, u32x4{w_[4 * q], w_[4 * q + 1], w_[4 * q + 2], w_[4 * q + 3]});
    }
    asm volatile("s_waitcnt lgkmcnt(0)" ::: "memory"); __builtin_amdgcn_s_barrier(); asm volatile("" ::: "memory");
    for (int j = 0; j < NT; ++j) {
      if (j + 2 < NT) B_WRITEK(j & 1);
      if (j + 1 < NT) B_WRITEV((j + 1) & 1);
      __builtin_amdgcn_sched_barrier(0);
      if (j + 3 < NT) B_LOADK(Kb, j + 3);
      if (j + 2 < NT) B_LOADV(Vb, j + 2);
      __builtin_amdgcn_sched_barrier(0);
      if (j == NT - 1) {
        const char* svl = vb0 + (j & 1) * VBYTES + r32 * VSTR + hh * 16;
        bf16x8 vf[4];
#pragma unroll
        for (int d = 0; d < 4; ++d) vf[d] = *(const bf16x8*)(svl + d * 32 * VSTR);
#pragma unroll
        for (int d = 0; d < 4; ++d) o[d] = __builtin_amdgcn_mfma_f32_32x32x16_bf16(vf[d], pb[0], o[d], 0, 0, 0);
      } else {
        constexpr int NQK = 2 * NS, NM = NQK + 16, RING = 8;
        const char* sk = kb0 + ((j + 1) & 1) * KBYTES + r32 * KSTR + hh * 16;
        const char* sv = vb0 + (j & 1) * VBYTES + r32 * VSTR + hh * 16;
        bf16x8 ring[RING];
        unsigned w_[16]; f32x2 ps2 = {0.f, 0.f};
#define B_FRAG(dst_, i_) do { if ((i_) < NQK) { dst_ = *(const bf16x8*)(sk + ((i_) & 1) * (32 * KSTR) + ((i_) >> 1) * 32); } \
          else { dst_ = *(const bf16x8*)(sv + (((i_) - NQK) & 3) * (32 * VSTR) + (((i_) - NQK) >> 2) * 32); } } while (0)
#pragma unroll
        for (int i = 0; i < 16; ++i) { s0[i] = 0.f; s1[i] = 0.f; }
#pragma unroll
        for (int i = 0; i < RING; ++i) B_FRAG(ring[i], i);
#pragma unroll
        for (int i = 0; i < NM; ++i) {
          if (i < NQK) {
            if (i & 1) s1 = __builtin_amdgcn_mfma_f32_32x32x16_bf16(ring[i % RING], qf[i >> 1], s1, 0, 0, 0);
            else       s0 = __builtin_amdgcn_mfma_f32_32x32x16_bf16(ring[i % RING], qf[i >> 1], s0, 0, 0, 0);
          } else {
            o[(i - NQK) & 3] = __builtin_amdgcn_mfma_f32_32x32x16_bf16(ring[i % RING], pb[(i - NQK) >> 2], o[(i - NQK) & 3], 0, 0, 0);
          }
          if (i + RING < NM) B_FRAG(ring[i % RING], i + RING);
          if (i >= NQK + 2) {
            const int g = i - NQK - 2;
            f32x2 v;
            if (g < 8) { v[0] = __builtin_amdgcn_exp2f(s0[2 * g]); v[1] = __builtin_amdgcn_exp2f(s0[2 * g + 1]); }
            else       { v[0] = __builtin_amdgcn_exp2f(s1[2 * (g - 8)]); v[1] = __builtin_amdgcn_exp2f(s1[2 * (g - 8) + 1]); }
            ps2 += v; w_[g] = cvtpk(v[0], v[1]);
          }
          __builtin_amdgcn_sched_barrier(0);
        }
#pragma unroll
        for (int g = 14; g < 16; ++g) { f32x2 v; v[0] = __builtin_amdgcn_exp2f(s1[2 * (g - 8)]); v[1] = __builtin_amdgcn_exp2f(s1[2 * (g - 8) + 1]); ps2 += v; w_[g] = cvtpk(v[0], v[1]); }
#undef B_FRAG
        if (j + 1 == NT - 1) {
          ps2 = f32x2{0.f, 0.f};
#pragma unroll
          for (int g = 0; g < 4; ++g) { ps2[0] += __builtin_amdgcn_exp2f(s0[2 * g]); ps2[1] += __builtin_amdgcn_exp2f(s0[2 * g + 1]); }
#pragma unroll
          for (int g = 4; g < 16; ++g) w_[g] = 0u;
        }
        if (j + 1 < NT) {
          l += ps2[0] + ps2[1];
#pragma unroll
          for (int q = 0; q < 4; ++q) pb[q] = __builtin_bit_cast(bf16x8, u32x4{w_[4 * q], w_[4 * q + 1], w_[4 * q + 2], w_[4 * q + 3]});
        }
      }
      asm volatile("s_waitcnt lgkmcnt(0)" ::: "memory"); __builtin_amdgcn_s_barrier(); asm volatile("" ::: "memory");
    }
    {
      const float inv = 1.f / xhalf_sum(l);
      u16* orow = O + (size_t)(sq * SEQ + pq - NMETA) * DM + hq * 128 + hh * 4;
#pragma unroll
      for (int d = 0; d < 4; ++d)
#pragma unroll
        for (int q = 0; q < 4; ++q) {
          u32x2 w = {cvtpk(o[d][4 * q] * inv, o[d][4 * q + 1] * inv), cvtpk(o[d][4 * q + 2] * inv, o[d][4 * q + 3] * inv)};
          *(u32x2*)(orow + d * 32 + q * 8) = w;
        }
    }
  }
  __syncthreads();
#undef B_LOADK
#undef B_LOADV
#undef B_WRITEK
#undef B_WRITEV
}

#define XB_TMO      128
#define XB_XCNT(j)  (256  + 64 * (j))
#define XB_XSUB(j)  (1280 + 64 * (j))
#define XB_XGEN(j)  (2304 + 64 * (j))
#define XB_TOP      3328
#define XB_TOPGEN   3392
#define XCD_BAR_WORDS 3456
#define XB_SPIN_CAP (1u << 18)
#define LAS3 __attribute__((address_space(3)))
DI unsigned xb_ld(unsigned* p) { return __hip_atomic_load(p, __ATOMIC_RELAXED, __HIP_MEMORY_SCOPE_AGENT); }
DI unsigned xb_add(unsigned* p, unsigned v) { return __hip_atomic_fetch_add(p, v, __ATOMIC_RELAXED, __HIP_MEMORY_SCOPE_AGENT); }
DI unsigned xb_xcc_id() { return (unsigned)__builtin_amdgcn_s_getreg((3 << 11) | 20) & 0xFu; }
#define XB_SPIN(cond, bar) do { unsigned _sp = 0; while (cond) { __builtin_amdgcn_s_sleep(1); \
    if ((++_sp & 255u) == 0u) { if (xb_ld(&(bar)[XB_TMO])) break; if (_sp > XB_SPIN_CAP) { atomicAdd(&(bar)[XB_TMO], 1u); break; } } } } while (0)
struct XcdBarrier { unsigned* bar; unsigned x; volatile LAS3 unsigned* st; };
DI XcdBarrier xcd_barrier_post(unsigned* bar, volatile LAS3 unsigned* st) {
  XcdBarrier b; b.bar = bar; b.x = xb_xcc_id(); b.st = st;
  if (threadIdx.x == 0) (void)xb_add(&bar[XB_XCNT(b.x)], 1u);
  return b;
}
DI void xcd_barrier_complete(unsigned* bar, unsigned x, unsigned& nloc, unsigned& nx) {
  const unsigned G = gridDim.x * gridDim.y * gridDim.z;
  unsigned sum, cnt, mine, sp = 0u;
  for (;;) {
    sum = 0u; cnt = 0u; mine = 0u;
#pragma unroll
    for (unsigned j = 0; j < 16; ++j) { const unsigned c = xb_ld(&bar[XB_XCNT(j)]); sum += c; cnt += (c > 0u) ? 1u : 0u; mine = (j == x) ? c : mine; }
    if (sum == G) break;
    __builtin_amdgcn_s_sleep(1);
    if ((++sp & 255u) == 0u) { if (xb_ld(&bar[XB_TMO])) break; if (sp > XB_SPIN_CAP) { atomicAdd(&bar[XB_TMO], 1u); break; } }
  }
  nloc = mine > 0u ? mine : 1u; nx = cnt > 0u ? cnt : 1u;
}
DI void xcd_barrier(unsigned* bar, const unsigned x, volatile LAS3 unsigned* st) {
  asm volatile("s_waitcnt vmcnt(0)" ::: "memory");
  __syncthreads();
  if (threadIdx.x == 0) {
    __builtin_amdgcn_s_waitcnt(0);
    unsigned nloc = st[0], nx = st[1];
    if (nloc == 0u) { xcd_barrier_complete(bar, x, nloc, nx); st[0] = nloc; st[1] = nx; }
    const unsigned old = xb_add(&bar[XB_XSUB(x)], 1u);
    const unsigned gen = old / nloc;
    if (old + 1u == (gen + 1u) * nloc) {
      __builtin_amdgcn_fence(__ATOMIC_RELEASE, "agent");
      asm volatile("s_waitcnt vmcnt(0)" ::: "memory");
      const unsigned og = xb_add(&bar[XB_TOP], 1u);
      const unsigned tg = og / nx;
      if (og + 1u == (tg + 1u) * nx) xb_add(&bar[XB_TOPGEN], 1u);
      else XB_SPIN(xb_ld(&bar[XB_TOPGEN]) == tg, bar);
      __builtin_amdgcn_fence(__ATOMIC_ACQUIRE, "agent");
      xb_add(&bar[XB_XGEN(x)], 1u);
      asm volatile("s_waitcnt vmcnt(0)" ::: "memory");
    } else {
      XB_SPIN(xb_ld(&bar[XB_XGEN(x)]) == gen, bar);
      __builtin_amdgcn_fence(__ATOMIC_ACQUIRE, "agent");
      asm volatile("s_waitcnt vmcnt(0)" ::: "memory");
    }
  }
  __syncthreads();
}
constexpr size_t O_BAR = 47 * MiB + 512 * 1024;

template <class Tp> DI Tp* uni(Tp* p) {
  const unsigned long long v = (unsigned long long)p;
  const unsigned lo = __builtin_amdgcn_readfirstlane((unsigned)v), hi = __builtin_amdgcn_readfirstlane((unsigned)(v >> 32));
  typedef __attribute__((address_space(1))) Tp* gptr_t;
  return (Tp*)(gptr_t)(((unsigned long long)hi << 32) | lo);
}
DI Params ld_params() {
  const volatile __attribute__((address_space(4))) Params* kp = (const volatile __attribute__((address_space(4))) Params*)__builtin_amdgcn_kernarg_segment_ptr();
  Params r;
#define LDF(f_) r.f_ = uni(kp->f_)
  LDF(xp); LDF(xs); LDF(meta); LDF(mix_g); LDF(ffn_g); LDF(w_in); LDF(q_a_g); LDF(kv_a_g); LDF(w_uq); LDF(w_ukv); LDF(q_g0); LDF(k_g0);
  LDF(conv_w); LDF(w_out0); LDF(w_qkv); LDF(q_g1); LDF(k_g1); LDF(w_out1); LDF(w1); LDF(w3); LDF(w2); LDF(out); LDF(ws); LDF(hmeta);
#undef LDF
  return r;
}
constexpr size_t O_W = OFF_W, O_SS = 46 * MiB, O_R1 = OFF_R1, O_R2 = OFF_R2, O_R3 = OFF_R3, O_HBA = 800 * MiB;
constexpr size_t O_Z = O_R2, O_QPRE = O_R2, O_KNPRE = O_R2 + 145 * MiB, O_CQN = O_R3, O_CKVN = O_R3 + 73 * MiB, O_VT0 = O_R3 + 122 * MiB,
                 O_KR = O_R3 + 220 * MiB, O_ACT = O_R2, O_QKPRE = O_R2, O_VT1 = O_R3, O_Q1 = O_R3 + 49 * MiB, O_K1 = O_R3 + 242 * MiB;
constexpr size_t O_K0_IN_OUT = 145 * MiB;
#define WSP(P_, off_) ((u16*)((P_).ws + (off_)))
#define WW(P_, woff_) (WSP(P_, O_W) + (woff_))

__global__ void __launch_bounds__(NTHREADS) fwd_megakernel(Params Punused) {
  extern __shared__ __attribute__((aligned(16))) char smem[];
  cg::grid_group grid = cg::this_grid();
  const int wv = __builtin_amdgcn_readfirstlane((int)(threadIdx.x >> 6));
  volatile LAS3 unsigned* xst = (volatile LAS3 unsigned*)(smem + pg8::STAGE_BYTES);
  if (threadIdx.x < 4) xst[threadIdx.x] = 0u;
  __syncthreads();
  { const Params P = ld_params(); (void)xcd_barrier_post((unsigned*)(P.ws + O_BAR), xst); }
#define GRID_BAR() do { const Params Pb_ = ld_params(); xcd_barrier((unsigned*)(Pb_.ws + O_BAR), xb_xcc_id(), xst); } while (0)
  {
    const Params P = ld_params();
    u16* W = WSP(P, O_W);
    transpose_job(P.w_in, W + W_IN, 1024, IN0, 4, nullptr, wv);
    transpose_job(P.w_uq, W + W_UQ, 384, 768, 0, P.q_a_g, wv);
    transpose_job(P.w_ukv, W + W_UKV, 256, 1024, 0, P.kv_a_g, wv);
    transpose_job(P.w_out0, W + W_OUT0, 1024, 1024, 0, nullptr, wv);
    transpose_job(P.w_qkv, W + W_QKV, 1024, 1536, 0, P.mix_g + DM, wv);
    transpose_job(P.w_out1, W + W_OUT1, 1024, 1024, 0, nullptr, wv);
    for (int l = 0; l < 2; ++l) {
      transpose_job(P.w1 + (size_t)l * 1024 * FFN, W + W_13 + (size_t)l * 5632 * 1024, 1024, FFN, 1, P.ffn_g + l * DM, wv);
      transpose_job(P.w3 + (size_t)l * 1024 * FFN, W + W_13 + (size_t)l * 5632 * 1024, 1024, FFN, 2, P.ffn_g + l * DM, wv);
      transpose_job(P.w2 + (size_t)l * 1024 * FFN, W + W_2 + (size_t)l * 1024 * FFN, FFN, 1024, 0, nullptr, wv);
    }
    norm_phase<true>(P, P.mix_g, WSP(P, O_R1), wv);
    float* ssq = (float*)(P.ws + O_SS);
    for (int i = obid() * NTHREADS + otid(wv); i < 3 * T; i += gridDim.x * NTHREADS) ssq[i] = 0.f;
    { float* ss2 = (float*)(P.ws + OFF_HM); for (int i = obid() * NTHREADS + otid(wv); i < 2 * T; i += gridDim.x * NTHREADS) ss2[i] = 0.f; }
  }
  grid.sync();
  { const Params P = ld_params();
    run_gemm(smem, WSP(P, O_R1), WW(P, W_IN), 2304, 1024, EpiZ{WSP(P, O_Z), WSP(P, O_CQN), WSP(P, O_CKVN), WSP(P, O_KR), (float*)(P.ws + OFF_HM), (float*)(P.ws + OFF_HM) + T}, 0, wv); }
  GRID_BAR();
  { const Params P = ld_params();
    e1_phase(P, WSP(P, O_Z), WSP(P, O_CQN), WSP(P, O_CKVN), WSP(P, O_KR), WSP(P, O_R1), wv); }
  GRID_BAR();
  { const Params P = ld_params();
    run_gemm(smem, WSP(P, O_CQN), WW(P, W_UQ), 768, 384, EpiStoreRS{WSP(P, O_QPRE), 768, (const float*)(P.ws + OFF_HM), 1.f / 384.f}, 0, wv); }
  { const Params P = ld_params();
    run_gemm(smem, WSP(P, O_CKVN), WW(P, W_UKV), 1024, 256, EpiKV0{WSP(P, O_KNPRE), WSP(P, O_VT0), (const float*)(P.ws + OFF_HM) + T}, (int)gridDim.x - (3 * (TP / 256)) % (int)gridDim.x, wv); }
  GRID_BAR();
  { const Params P = ld_params();
    e2_phase(P, WSP(P, O_QPRE), WSP(P, O_KNPRE), WSP(P, O_KR), (u16*)P.out, (u16*)((char*)P.out + O_K0_IN_OUT), wv);
    zero_vt_pad(WSP(P, O_VT0), NSEQ * 4 * 128, wv); }
  GRID_BAR();
  { const Params P = ld_params();
    attn_phase<192, 4, 4, true>((const u16*)P.out, (const u16*)((char*)P.out + O_K0_IN_OUT), WSP(P, O_VT0), WSP(P, O_R1), P.q_g0, P.k_g0, smem, wv); }
  GRID_BAR();
  { const Params P = ld_params();
    run_gemm(smem, WSP(P, O_R1), WW(P, W_OUT0), 1024, 1024, EpiRes<0>{P, nullptr, WSP(P, O_HBA), (float*)(P.ws + O_SS)}, 0, wv); }
  GRID_BAR();
  { const Params P = ld_params();
    run_gemm(smem, WSP(P, O_HBA), WW(P, W_13), 5632, 1024, EpiSwiglu{WSP(P, O_ACT), (const float*)(P.ws + O_SS)}, 0, wv); }
  GRID_BAR();
  { const Params P = ld_params();
    run_gemm(smem, WSP(P, O_ACT), WW(P, W_2), 1024, FFN, EpiRes<1>{P, WSP(P, O_HBA), WSP(P, O_R1), (float*)(P.ws + O_SS) + T}, 0, wv); }
  GRID_BAR();
  { const Params P = ld_params();
    run_gemm(smem, WSP(P, O_R1), WW(P, W_QKV), 1536, 1024, EpiQKV1{WSP(P, O_QKPRE), WSP(P, O_VT1), (const float*)(P.ws + O_SS) + T}, 0, wv); }
  GRID_BAR();
  { const Params P = ld_params();
    e3_phase(P, WSP(P, O_QKPRE), WSP(P, O_K1), wv);
    zero_vt_pad(WSP(P, O_VT1), NSEQ * 2 * 128, wv); }
  GRID_BAR();
  { const Params P = ld_params();
    attn_phase_l1<8, 2>(WSP(P, O_QKPRE), WSP(P, O_K1), WSP(P, O_VT1), (u16*)P.out, P.q_g1, smem, wv); }
  GRID_BAR();
  { const Params P = ld_params();
    run_gemm(smem, (const u16*)P.out, WW(P, W_OUT1), 1024, 1024, EpiRes<3>{P, WSP(P, O_R1), WSP(P, O_HBA), (float*)(P.ws + O_SS) + 2 * T}, 0, wv, TQ); }
  GRID_BAR();
  { const Params P = ld_params();
    run_gemm(smem, WSP(P, O_HBA), WW(P, W_13 + (size_t)5632 * 1024), 5632, 1024, EpiSwiglu{WSP(P, O_ACT), (const float*)(P.ws + O_SS) + 2 * T}, 0, wv, TQ); }
  GRID_BAR();
  { const Params P = ld_params();
    run_gemm(smem, WSP(P, O_ACT), WW(P, W_2 + (size_t)1024 * FFN), 1024, FFN, EpiRes<4>{P, WSP(P, O_HBA), nullptr, nullptr}, 0, wv, TQ); }
}

extern "C" void kernel_launch(void* const* d_in, const int* in_sizes, int n_in, void* d_out, int out_size, void* d_ws, size_t ws_size,
                              hipStream_t stream) {
  static int grid_blocks = 0;
  if (!grid_blocks) {
    if (hipFuncSetAttribute((const void*)fwd_megakernel, hipFuncAttributeMaxDynamicSharedMemorySize, SMEM_BYTES) != hipSuccess)
      fprintf(stderr, "kernel_launch: hipFuncSetAttribute failed\n");
    int dev = 0, cus = 0, per_cu = 0;
    hipGetDevice(&dev);
    hipDeviceGetAttribute(&cus, hipDeviceAttributeMultiprocessorCount, dev);
    if (hipOccupancyMaxActiveBlocksPerMultiprocessor(&per_cu, (const void*)fwd_megakernel, NTHREADS, SMEM_BYTES) != hipSuccess || per_cu < 1) per_cu = 1;
    (void)hipGetLastError();
    grid_blocks = cus * per_cu;
  }
  Params p;
  memset(&p, 0, sizeof(p));
  p.xp = (const float*)d_in[0]; p.xs = (const float*)d_in[1]; p.meta = (const float*)d_in[2]; p.mix_g = (const float*)d_in[3];
  p.ffn_g = (const float*)d_in[4]; p.w_in = (const float*)d_in[5]; p.q_a_g = (const float*)d_in[6]; p.kv_a_g = (const float*)d_in[7];
  p.w_uq = (const float*)d_in[8]; p.w_ukv = (const float*)d_in[9]; p.q_g0 = (const float*)d_in[10]; p.k_g0 = (const float*)d_in[11];
  p.conv_w = (const float*)d_in[12]; p.w_out0 = (const float*)d_in[13]; p.w_qkv = (const float*)d_in[14]; p.q_g1 = (const float*)d_in[15];
  p.k_g1 = (const float*)d_in[16]; p.w_out1 = (const float*)d_in[17]; p.w1 = (const float*)d_in[18]; p.w3 = (const float*)d_in[19];
  p.w2 = (const float*)d_in[20];
  p.out = (float*)d_out; p.ws = (char*)d_ws; p.hmeta = (float*)((char*)d_ws + OFF_HM);
  (void)hipMemsetAsync((char*)d_ws + O_BAR, 0, XCD_BAR_WORDS * sizeof(unsigned), stream);
  void* args[] = {&p};
  hipError_t e = hipLaunchCooperativeKernel((const void*)fwd_megakernel, dim3(grid_blocks), dim3(NTHREADS), args, SMEM_BYTES, stream);
  if (e != hipSuccess) fprintf(stderr, "cooperative launch failed: %s (grid %d)\n", hipGetErrorString(e), grid_blocks);
}
```
